# Optimizing an MI355X kernel written in HIP

```python
import math
import jax, jax.numpy as jnp
from jax import lax
import numpy as np

D_MODEL = 2048
BATCH = 2
SEQ = 4096
DEPTH = 1

HEAD_DIM = 128
MIX_WIDTH = D_MODEL
N_RET_HEADS = MIX_WIDTH // HEAD_DIM // 2
N_DIFF_HEADS = MIX_WIDTH // HEAD_DIM // 2
RET_DK = HEAD_DIM
RET_DV = HEAD_DIM
RET_WIDTH = N_RET_HEADS * RET_DV
DIFF_DQK = HEAD_DIM // 2
DIFF_DV = HEAD_DIM
DIFF_WIDTH = N_DIFF_HEADS * DIFF_DV
D_FF = 4 * D_MODEL
RET_CHUNK = 128
Q_BLOCK = 128
ROPE_THETA = 500000.0
RET_THETA = 10000.0
DIFF_ROT_DIM = DIFF_DQK // 4
NORM_EPS = 1e-6
GN_EPS = 1e-5
IN_SPLITS = (RET_WIDTH, RET_WIDTH, RET_WIDTH, RET_WIDTH,
             N_DIFF_HEADS * 2 * DIFF_DQK, N_DIFF_HEADS * 2 * DIFF_DQK, DIFF_WIDTH)
IN_WIDTH = sum(IN_SPLITS)

kernel_name = "hybrid_retention_diffattn_block"


def lambda_init(layer_idx):
    return 0.8 - 0.6 * math.exp(-0.3 * layer_idx)


def rms_norm(x, w, eps=NORM_EPS):
    xf = x.astype(jnp.float32)
    y = xf * lax.rsqrt(jnp.mean(xf * xf, axis=-1, keepdims=True) + eps)
    return (y * w.astype(jnp.float32)).astype(x.dtype)


def modulate(h, shift, scale):
    return h * (1.0 + scale[:, None, :]) + shift[:, None, :]


def rotary(x, rot_dim, base):
    T = x.shape[-2]
    pos = jnp.arange(T, dtype=jnp.float32)
    inv = base ** (-jnp.arange(0, rot_dim, 2, dtype=jnp.float32) / rot_dim)
    ang = pos[:, None] * inv[None, :]
    cos = jnp.cos(ang).astype(x.dtype)
    sin = jnp.sin(ang).astype(x.dtype)
    half = rot_dim // 2
    x1 = x[..., :half]
    x2 = x[..., half:rot_dim]
    return jnp.concatenate([x1 * cos - x2 * sin, x2 * cos + x1 * sin, x[..., rot_dim:]], axis=-1)


def retention_chunkwise(q, k, v, log_gamma):
    B, H, T, dk = q.shape
    dv = v.shape[-1]
    C = RET_CHUNK
    NC = T // C
    idx = jnp.arange(C, dtype=jnp.float32)
    rel = idx[:, None] - idx[None, :]
    lg = log_gamma[:, None, None]
    decay = jnp.where(rel[None] >= 0, jnp.exp(jnp.maximum(rel, 0.0)[None] * lg), 0.0)
    xi = jnp.exp((idx + 1.0)[None, :] * log_gamma[:, None])
    zeta = jnp.exp((C - 1.0 - idx)[None, :] * log_gamma[:, None])
    chunk_decay = jnp.exp(C * log_gamma)

    def to_chunks(t):
        return t.reshape(B, H, NC, C, t.shape[-1]).transpose(2, 0, 1, 3, 4)

    def step(S, inp):
        qc, kc, vc = inp
        inner = jnp.einsum('bhid,bhjd->bhij', qc, kc) * decay[None]
        o = jnp.einsum('bhij,bhjv->bhiv', inner, vc)
        o = o + jnp.einsum('bhid,bhdv->bhiv', qc, S) * xi[None, :, :, None]
        S = S * chunk_decay[None, :, None, None] + jnp.einsum(
            'bhjd,bhjv->bhdv', kc * zeta[None, :, :, None], vc)
        return S, o

    S0 = jnp.zeros((B, H, dk, dv), jnp.float32)
    _, o = lax.scan(step, S0, (to_chunks(q), to_chunks(k), to_chunks(v)))
    return o.transpose(1, 2, 0, 3, 4).reshape(B, H, T, dv)


def diff_attention(q, k, v, lam):
    T = q.shape[3]
    nb = T // Q_BLOCK
    scale = DIFF_DQK ** -0.5
    kpos = jnp.arange(T)

    def block(i):
        qb = lax.dynamic_slice_in_dim(q, i * Q_BLOCK, Q_BLOCK, axis=3)
        s = jnp.einsum('bhcqd,bhckd->bhcqk', qb, k) * scale
        qpos = i * Q_BLOCK + jnp.arange(Q_BLOCK)
        mask = kpos[None, :] <= qpos[:, None]
        s = jnp.where(mask, s, -jnp.inf)
        p = jax.nn.softmax(s, axis=-1)
        a = p[:, :, 0] - lam * p[:, :, 1]
        return jnp.einsum('bhqk,bhkd->bhqd', a, v)

    o = lax.map(block, jnp.arange(nb))
    B, H = q.shape[0], q.shape[1]
    return o.transpose(1, 2, 0, 3, 4).reshape(B, H, T, v.shape[-1])


def setup_inputs(seed: int = 0) -> dict:
    key = jax.random.key(seed)
    ks = jax.random.split(key, 18)
    f32 = jnp.float32
    x = jax.random.normal(ks[0], (BATCH, SEQ, D_MODEL), f32)
    c = jax.random.normal(ks[1], (BATCH, D_MODEL), f32)
    w_ada = jax.random.normal(ks[2], (DEPTH, D_MODEL, 6 * D_MODEL), f32) * (0.5 * D_MODEL ** -0.5)
    b_ada = jax.random.normal(ks[3], (DEPTH, 6 * D_MODEL), f32) * 0.02
    norm1_w = 1.0 + 0.05 * jax.random.normal(ks[4], (DEPTH, D_MODEL), f32)
    norm2_w = 1.0 + 0.05 * jax.random.normal(ks[5], (DEPTH, D_MODEL), f32)
    w_in = jax.random.normal(ks[6], (DEPTH, D_MODEL, IN_WIDTH), f32) * D_MODEL ** -0.5
    ret_gn_w = 1.0 + 0.05 * jax.random.normal(ks[7], (DEPTH, RET_WIDTH), f32)
    diff_lq1 = 0.1 * jax.random.normal(ks[8], (DEPTH, DIFF_DQK), f32)
    diff_lk1 = 0.1 * jax.random.normal(ks[9], (DEPTH, DIFF_DQK), f32)
    diff_lq2 = 0.1 * jax.random.normal(ks[10], (DEPTH, DIFF_DQK), f32)
    diff_lk2 = 0.1 * jax.random.normal(ks[11], (DEPTH, DIFF_DQK), f32)
    diff_subln_w = 1.0 + 0.05 * jax.random.normal(ks[12], (DEPTH, DIFF_WIDTH), f32)
    w_out = jax.random.normal(ks[13], (DEPTH, MIX_WIDTH, D_MODEL), f32) * MIX_WIDTH ** -0.5
    w_mlp1 = jax.random.normal(ks[14], (DEPTH, D_MODEL, D_FF), f32) * D_MODEL ** -0.5
    w_mlp2 = jax.random.normal(ks[15], (DEPTH, D_FF, D_MODEL), f32) * D_FF ** -0.5
    final_norm_w = 1.0 + 0.05 * jax.random.normal(ks[16], (D_MODEL,), f32)
    return {"x": x, "c": c, "w_ada": w_ada, "b_ada": b_ada, "norm1_w": norm1_w,
            "norm2_w": norm2_w, "w_in": w_in, "ret_gn_w": ret_gn_w,
            "diff_lq1": diff_lq1, "diff_lk1": diff_lk1, "diff_lq2": diff_lq2,
            "diff_lk2": diff_lk2, "diff_subln_w": diff_subln_w, "w_out": w_out,
            "w_mlp1": w_mlp1, "w_mlp2": w_mlp2, "final_norm_w": final_norm_w}


def reference(x, c, w_ada, b_ada, norm1_w, norm2_w, w_in, ret_gn_w, diff_lq1, diff_lk1,
              diff_lq2, diff_lk2, diff_subln_w, w_out, w_mlp1, w_mlp2, final_norm_w):
    B, T, _ = x.shape
    f32 = jnp.float32
    log_gamma = jnp.log(1.0 - 2.0 ** (-5.0 - jnp.arange(N_RET_HEADS, dtype=f32)))
    split_pts = list(np.cumsum(IN_SPLITS)[:-1])
    silu_c = jax.nn.silu(c)

    for l in range(DEPTH):
        mod = silu_c @ w_ada[l] + b_ada[l]
        sh1, sc1, g1, sh2, sc2, g2 = jnp.split(mod, 6, axis=-1)

        h = modulate(rms_norm(x, norm1_w[l]), sh1, sc1)
        proj = h @ w_in[l]
        rq, rk, rv, rg, dq, dk, dv = jnp.split(proj, split_pts, axis=-1)

        def heads(t, d):
            return t.reshape(B, T, -1, d).transpose(0, 2, 1, 3).astype(f32)
        rq_h = rotary(heads(rq, RET_DK), RET_DK, RET_THETA)
        rk_h = rotary(heads(rk, RET_DK), RET_DK, RET_THETA) * (RET_DK ** -0.5)
        rv_h = heads(rv, RET_DV)
        y_ret = retention_chunkwise(rq_h, rk_h, rv_h, log_gamma)
        mu = jnp.mean(y_ret, axis=-1, keepdims=True)
        var = jnp.mean(jnp.square(y_ret - mu), axis=-1, keepdims=True)
        y_ret = (y_ret - mu) * lax.rsqrt(var + GN_EPS)
        y_ret = y_ret.transpose(0, 2, 1, 3).reshape(B, T, RET_WIDTH) * ret_gn_w[l].astype(f32)
        y_ret = y_ret * jax.nn.silu(rg.astype(f32))

        dq_h = dq.reshape(B, T, N_DIFF_HEADS, 2, DIFF_DQK).transpose(0, 2, 3, 1, 4).astype(f32)
        dk_h = dk.reshape(B, T, N_DIFF_HEADS, 2, DIFF_DQK).transpose(0, 2, 3, 1, 4).astype(f32)
        dq_h = rotary(dq_h, DIFF_ROT_DIM, ROPE_THETA)
        dk_h = rotary(dk_h, DIFF_ROT_DIM, ROPE_THETA)
        dv_h = heads(dv, DIFF_DV)
        lam_init = lambda_init(l)
        lam = (jnp.exp(jnp.sum(diff_lq1[l].astype(f32) * diff_lk1[l].astype(f32)))
               - jnp.exp(jnp.sum(diff_lq2[l].astype(f32) * diff_lk2[l].astype(f32)))
               + lam_init)
        y_dif = diff_attention(dq_h, dk_h, dv_h, lam)
        y_dif = y_dif * lax.rsqrt(jnp.mean(y_dif * y_dif, axis=-1, keepdims=True) + GN_EPS)
        y_dif = y_dif.transpose(0, 2, 1, 3).reshape(B, T, DIFF_WIDTH)
        y_dif = y_dif * diff_subln_w[l].astype(f32) * (1.0 - lam_init)

        mixed = jnp.concatenate([y_ret, y_dif], axis=-1).astype(x.dtype) @ w_out[l]
        x = x + g1[:, None, :] * mixed

        h2 = modulate(rms_norm(x, norm2_w[l]), sh2, sc2)
        mlp = jnp.square(jax.nn.relu(h2 @ w_mlp1[l])) @ w_mlp2[l]
        x = x + g2[:, None, :] * mlp

    return rms_norm(x, final_norm_w)
```

```cpp
#include <hip/hip_runtime.h>
#include <hip/hip_cooperative_groups.h>
#include <cstdio>
#include <cstdint>
#include <cmath>
namespace cg = cooperative_groups;
namespace pg8 {
#define PG8_LAS __attribute__((address_space(3)))
typedef unsigned short bf16_t;
typedef short bf16x8 __attribute__((ext_vector_type(8)));
typedef float f32x4 __attribute__((ext_vector_type(4)));
typedef unsigned u32x4 __attribute__((ext_vector_type(4)));
constexpr int BM = 256, BK = 64, HALF = 128, HTB = HALF * BK * 2  , STAGE_BYTES = 8 * HTB, NXCD = 8, WGM = 8;

__host__ __device__ __forceinline__ int lds_byte(int r, int c) { const int st = (r >> 4) * 2 + (c >> 5), rr = r & 15, cc = c & 31, ob = rr * 64 + cc * 2; return st * 1024 + (ob ^ (((ob >> 9) & 1) << 5)); }
__host__ __device__ __forceinline__ void stage_rc(int b, int& R, int& C) { const int st = b / 1024, sb = b % 1024, swz = sb ^ (((sb >> 9) & 1) << 5); R = (st >> 1) * 16 + swz / 64; C = (st & 1) * 32 + (swz % 64) / 2; }
__host__ __device__ __forceinline__ int perm32(int rho) { const int n = rho >> 4, i = rho & 15; return 8 * (i >> 2) + 4 * n + (i & 3); }

struct Unit { int pm, pn; };
struct Gemm { const bf16_t* A; const bf16_t* Bt; int M, N, K; };

struct StaticOrder {
    int nM, nN, nwg, G, c;
    __host__ __device__ void init(int M, int N, int G_, int c_) { nM = M / BM; nN = N / BM; nwg = nM * nN; G = G_; c = c_; }
    __host__ __device__ bool next(int i, Unit& u) const {
        const long L = (long)i * G + c; if (L >= nwg) return false;
        int wgid = (int)L; { const int q = nwg / NXCD, r = nwg % NXCD, xcd = wgid % NXCD, off = wgid / NXCD; wgid = (xcd < r ? xcd * (q + 1) : r * (q + 1) + (xcd - r) * q) + off; }
        const int nig = WGM * nN, gid = wgid / nig, fm = gid * WGM, gsz = (nM - fm) < WGM ? (nM - fm) : WGM;
        u.pm = fm + ((wgid % nig) % gsz); u.pn = (wgid % nig) / gsz; return true;
    }
    __device__ __forceinline__ void a_ready(const Unit&) const {}
    __device__ __forceinline__ void done(const Unit&) const {}
};
__device__ __forceinline__ unsigned cvt_pk_bf16(float lo, float hi) { unsigned r; asm volatile("v_cvt_pk_bf16_f32 %0, %1, %2" : "=v"(r) : "v"(lo), "v"(hi)); return r; }
template <class Epi, class Sched, bool ALIGN_EPI = false, bool SP2 = false>
__device__ __forceinline__ void gemm_phase(PG8_LAS unsigned char* lds, const Gemm g, const Sched& S, const Epi& E) {
    int tid_ = threadIdx.x; asm volatile("" : "+v"(tid_));
    const int tid = tid_, wid = __builtin_amdgcn_readfirstlane(tid >> 6), lane = tid & 63, wr = wid >> 2, wc = wid & 3, fr = lane & 15, fq = lane >> 4;
    const int K = g.K, nt = K / BK;
    unsigned voffA[2], voffB[2];
#pragma unroll
    for (int i = 0; i < 2; ++i) { int R, C; stage_rc(tid * 16 + i * 8192, R, C); const int Rb = Epi::PERM ? ((R & ~31) + perm32(R & 31)) : R;
        voffA[i] = (unsigned)(R * K + C) * 2u; voffB[i] = (unsigned)(Rb * K + C) * 2u; }
    const size_t kstep = (size_t)(BK * 2);
    const size_t hstep = (size_t)HALF * K * 2;
    const size_t tstep = 2 * hstep;
    const unsigned ldsw = (unsigned)wid * 1024u;
    const int aoff = lds_byte(wr * 64 + fr, fq * 8), boff = lds_byte(wc * 32 + fr, fq * 8);
#define PG8_SA(b, h) (((b) * 2 + (h)) * HTB)
#define PG8_SB(b, h) ((4 + (b) * 2 + (h)) * HTB)
#define PG8_STAGE(bufoff, gbase, voff) do { _Pragma("unroll") for (int _i = 0; _i < 2; ++_i) \
        __builtin_amdgcn_global_load_lds((const unsigned*)((const char*)(gbase) + (voff)[_i]), (PG8_LAS unsigned*)(lds + (bufoff) + ldsw + _i * 8192), 16, 0, 0); } while (0)
#define PG8_LDA(dst, b, h) do { _Pragma("unroll") for (int m = 0; m < 4; ++m) _Pragma("unroll") for (int k = 0; k < 2; ++k) dst[m][k] = *(const PG8_LAS bf16x8*)(lds + PG8_SA(b, h) + aoff + m * 2048 + k * 1024); } while (0)
#define PG8_LDB(dst, b, h) do { _Pragma("unroll") for (int n = 0; n < 2; ++n) _Pragma("unroll") for (int k = 0; k < 2; ++k) dst[n][k] = *(const PG8_LAS bf16x8*)(lds + PG8_SB(b, h) + boff + n * 2048 + k * 1024); } while (0)
#define PG8_MMA(ai, bj, At, Bt) do { __builtin_amdgcn_s_setprio(1); _Pragma("unroll") for (int m = 0; m < 4; ++m) _Pragma("unroll") for (int n = 0; n < 2; ++n) _Pragma("unroll") for (int k = 0; k < 2; ++k) \
        acc[ai][bj][m][n] = __builtin_amdgcn_mfma_f32_16x16x32_bf16(Bt[n][k], At[m][k], acc[ai][bj][m][n], 0, 0, 0); __builtin_amdgcn_s_setprio(0); } while (0)
#define PG8_WAIT_V(n) asm volatile("s_waitcnt vmcnt(" #n ")" ::: "memory")
#define PG8_WAIT_L(n) asm volatile("s_waitcnt lgkmcnt(" #n ")" ::: "memory")
#define PG8_BAR __builtin_amdgcn_s_barrier()
#define PG8_SCHED __builtin_amdgcn_sched_barrier(0)
    Unit cur, nxt; int ui = 0;
    if (!S.next(0, cur)) return;
    f32x4 acc[2][2][4][2];
#pragma unroll
    for (int a = 0; a < 2; ++a)
#pragma unroll
        for (int b = 0; b < 2; ++b)
#pragma unroll
            for (int m = 0; m < 4; ++m)
#pragma unroll
                for (int n = 0; n < 2; ++n) acc[a][b][m][n] = (f32x4){0.f, 0.f, 0.f, 0.f};
    bf16x8 At[4][2], B0[2][2], B1[2][2];
    const char* cA = (const char*)g.A + (size_t)cur.pm * tstep; const char* cB = (const char*)g.Bt + (size_t)cur.pn * tstep;
    S.a_ready(cur);
    if constexpr (SP2) {
        PG8_STAGE(PG8_SB(0, 0), cB, voffB); PG8_STAGE(PG8_SB(0, 1), cB + hstep, voffB); PG8_STAGE(PG8_SA(0, 0), cA, voffA); PG8_STAGE(PG8_SA(0, 1), cA + hstep, voffA);
        if (wr == 1) PG8_BAR;
        PG8_WAIT_V(2); PG8_BAR;
        PG8_STAGE(PG8_SB(1, 0), cB + kstep, voffB); PG8_STAGE(PG8_SA(1, 0), cA + kstep, voffA); PG8_STAGE(PG8_SB(1, 1), cB + hstep + kstep, voffB);
        PG8_WAIT_V(6); PG8_BAR;
    } else {
        PG8_STAGE(PG8_SB(0, 0), cB, voffB); PG8_STAGE(PG8_SA(0, 0), cA, voffA); PG8_STAGE(PG8_SB(0, 1), cB + hstep, voffB); PG8_STAGE(PG8_SA(0, 1), cA + hstep, voffA);
        if (wr == 1) PG8_BAR;
        PG8_WAIT_V(4); PG8_BAR;
        PG8_STAGE(PG8_SB(1, 0), cB + kstep, voffB); PG8_STAGE(PG8_SA(1, 0), cA + kstep, voffA); PG8_STAGE(PG8_SB(1, 1), cB + hstep + kstep, voffB);
        PG8_WAIT_V(6); PG8_BAR;
    }
    for (;;) {
        const bool has_next = S.next(ui + 1, nxt);
        const char* nA = has_next ? (const char*)g.A + (size_t)nxt.pm * tstep : cA; const char* nB = has_next ? (const char*)g.Bt + (size_t)nxt.pn * tstep : cB;
        for (int t = 0; t < nt; t += 2) {
            const bool last = (t == nt - 2);
            const char* a1 = cA + (size_t)(t + 1) * kstep;
            const char* a2 = last ? nA : cA + (size_t)(t + 2) * kstep; const char* b2 = last ? nB : cB + (size_t)(t + 2) * kstep;
            const char* a3 = a2 + kstep; const char* b3 = b2 + kstep;
            if (last && has_next) S.a_ready(nxt);
            if constexpr (SP2) {
            PG8_LDB(B0, 0, 0); PG8_LDB(B1, 0, 1); PG8_SCHED; PG8_LDA(At, 0, 0); PG8_STAGE(PG8_SA(1, 1), a1 + hstep, voffA);
            PG8_WAIT_V(8); PG8_WAIT_L(0); PG8_BAR; PG8_MMA(0, 0, At, B0); PG8_MMA(0, 1, At, B1); PG8_BAR; PG8_SCHED;
            PG8_LDA(At, 0, 1); PG8_STAGE(PG8_SB(0, 0), b2, voffB); PG8_STAGE(PG8_SB(0, 1), b2 + hstep, voffB); PG8_STAGE(PG8_SA(0, 0), a2, voffA);
            PG8_WAIT_V(8); PG8_WAIT_L(0); PG8_BAR; PG8_MMA(1, 0, At, B0); PG8_MMA(1, 1, At, B1); PG8_BAR; PG8_SCHED;
            PG8_LDB(B0, 1, 0); PG8_LDB(B1, 1, 1); PG8_SCHED; PG8_LDA(At, 1, 0); PG8_STAGE(PG8_SA(0, 1), a2 + hstep, voffA);
            PG8_WAIT_V(8); PG8_WAIT_L(0); PG8_BAR; PG8_MMA(0, 0, At, B0); PG8_MMA(0, 1, At, B1); PG8_BAR; PG8_SCHED;
            PG8_LDA(At, 1, 1); PG8_STAGE(PG8_SB(1, 0), b3, voffB); PG8_STAGE(PG8_SB(1, 1), b3 + hstep, voffB); PG8_STAGE(PG8_SA(1, 0), a3, voffA);
            PG8_WAIT_V(8); PG8_WAIT_L(0); PG8_BAR; PG8_MMA(1, 0, At, B0); PG8_MMA(1, 1, At, B1); PG8_BAR; PG8_SCHED;
            } else {
            PG8_LDB(B0, 0, 0); PG8_SCHED; PG8_LDA(At, 0, 0); PG8_STAGE(PG8_SA(1, 1), a1 + hstep, voffA);
            PG8_WAIT_L(8); PG8_BAR; PG8_WAIT_L(0); PG8_MMA(0, 0, At, B0); PG8_BAR; PG8_SCHED;
            PG8_LDB(B1, 0, 1); PG8_STAGE(PG8_SB(0, 0), b2, voffB);
            PG8_BAR; PG8_WAIT_L(0); PG8_MMA(0, 1, At, B1); PG8_BAR;
            PG8_LDA(At, 0, 1); PG8_STAGE(PG8_SA(0, 0), a2, voffA);
            PG8_BAR; PG8_WAIT_L(0); PG8_MMA(1, 0, At, B0); PG8_BAR; PG8_SCHED;
            PG8_STAGE(PG8_SB(0, 1), b2 + hstep, voffB);
            PG8_WAIT_V(6); PG8_BAR; PG8_MMA(1, 1, At, B1); PG8_BAR;
            PG8_LDB(B0, 1, 0); PG8_SCHED; PG8_LDA(At, 1, 0); PG8_STAGE(PG8_SA(0, 1), a2 + hstep, voffA);
            PG8_WAIT_L(8); PG8_BAR; PG8_WAIT_L(0); PG8_MMA(0, 0, At, B0); PG8_BAR; PG8_SCHED;
            PG8_LDB(B1, 1, 1); PG8_STAGE(PG8_SB(1, 0), b3, voffB);
            PG8_BAR; PG8_WAIT_L(0); PG8_MMA(0, 1, At, B1); PG8_BAR;
            PG8_LDA(At, 1, 1); PG8_STAGE(PG8_SA(1, 0), a3, voffA);
            PG8_BAR; PG8_WAIT_L(0); PG8_MMA(1, 0, At, B0); PG8_BAR; PG8_SCHED;
            PG8_STAGE(PG8_SB(1, 1), b3 + hstep, voffB);
            PG8_WAIT_V(6); PG8_BAR; PG8_MMA(1, 1, At, B1); PG8_BAR;
            }
        }
        if constexpr (ALIGN_EPI) { if (wr == 0) PG8_BAR; }
        if constexpr (!Epi::AFTER_DRAIN) { E(acc, cur, wr, wc, fr, fq); S.done(cur); }
        if (!has_next) break;
#pragma unroll
        for (int a = 0; a < 2; ++a)
#pragma unroll
            for (int b = 0; b < 2; ++b)
#pragma unroll
                for (int m = 0; m < 4; ++m)
#pragma unroll
                    for (int n = 0; n < 2; ++n) acc[a][b][m][n] = (f32x4){0.f, 0.f, 0.f, 0.f};
        cur = nxt; cA = nA; cB = nB; ++ui;
        if constexpr (ALIGN_EPI) { if (wr == 1) PG8_BAR; }
    }
    PG8_WAIT_V(0);
    if constexpr (!ALIGN_EPI) { if (wr == 0) PG8_BAR; }
    PG8_BAR;
    if constexpr (Epi::AFTER_DRAIN) { E.fused(acc, cur, wr, wc, fr, fq, lds, wid, lane); S.done(cur); }
#undef PG8_SA
#undef PG8_SB
#undef PG8_STAGE
#undef PG8_LDA
#undef PG8_LDB
#undef PG8_MMA
#undef PG8_WAIT_V
#undef PG8_WAIT_L
#undef PG8_BAR
#undef PG8_SCHED
}
}

#define LAS __attribute__((address_space(3)))
typedef unsigned short bf16_t;
typedef short bf16x8 __attribute__((ext_vector_type(8)));
typedef short s16x4 __attribute__((ext_vector_type(4)));
typedef float f32x4 __attribute__((ext_vector_type(4)));
typedef float f32x2 __attribute__((ext_vector_type(2)));
typedef unsigned u32x4 __attribute__((ext_vector_type(4)));
typedef unsigned u32x2 __attribute__((ext_vector_type(2)));
typedef __bf16 bf16x2_t __attribute__((ext_vector_type(2)));
typedef LAS unsigned char lds_t;

constexpr int BATCH = 2, SEQ = 4096, DM = 2048, M = BATCH * SEQ, NPROJ = 7168, FF = 8192, NMOD = 6 * DM;
constexpr int NTHREADS = 512, NWAVES = 8;
constexpr size_t MiB = 1u << 20;
constexpr size_t WS_CTL = 0, CTL_ZERO_BYTES = 65536;
constexpr size_t WS_MOD = 1 * MiB;
constexpr size_t WS_ROTR = 2 * MiB;
constexpr size_t WS_ROTD = 4 * MiB;
constexpr size_t WS_WIN = 5 * MiB;
constexpr size_t WS_WOUT = 33 * MiB;
constexpr size_t WS_W1 = 41 * MiB;
constexpr size_t WS_W2 = 73 * MiB;
constexpr size_t WS_XN = 105 * MiB;
constexpr size_t WS_RQ = 137 * MiB, WS_RK = 153 * MiB, WS_RKT = 169 * MiB, WS_RVT = 185 * MiB, WS_RG = 201 * MiB, WS_DQ = 217 * MiB, WS_DK = 233 * MiB, WS_DVT = 249 * MiB;
constexpr size_t WS_U = 137 * MiB;
constexpr size_t WS_MIX = 265 * MiB;
constexpr size_t WS_X1 = 297 * MiB;
constexpr size_t WS_END = 361 * MiB;
constexpr int LDS_BYTES = 149504;

__device__ __forceinline__ unsigned cvtpk(float lo, float hi) { f32x2 v = {lo, hi}; bf16x2_t b = __builtin_convertvector(v, bf16x2_t); return __builtin_bit_cast(unsigned, b); }
__device__ __forceinline__ unsigned short f2bf(float f) { return (unsigned short)(cvtpk(f, 0.f) & 0xffffu); }
__device__ __forceinline__ float bf2f(unsigned short b) { return __builtin_bit_cast(float, (unsigned)b << 16); }
__device__ __forceinline__ bf16x8 pack8(f32x4 a, f32x4 b) { u32x4 r; r.x = cvtpk(a[0], a[1]); r.y = cvtpk(a[2], a[3]); r.z = cvtpk(b[0], b[1]); r.w = cvtpk(b[2], b[3]); return __builtin_bit_cast(bf16x8, r); }
__device__ __forceinline__ float wave_sum(float v) {
#pragma unroll
    for (int o = 1; o < 64; o <<= 1) v += __shfl_xor(v, o);
    return v;
}
#define MFMA16(a, b, c) __builtin_amdgcn_mfma_f32_16x16x32_bf16((a), (b), (c), 0, 0, 0)

struct Args {
    const float* in[17]; float* out; unsigned char* ws;
    double inv_r[64]; double inv_d[8];
};

__device__ __forceinline__ int win_dest_row(int n) {
    if (n < 2048) { const int d = n & 127; return (n & ~127) + 32 * ((d >> 4) & 3) + 8 * ((d >> 2) & 3) + 4 * (d >> 6) + (d & 3); }
    if (n >= 4096 && n < 6144) { const int d = n & 63; if (d < 16) return (n & ~63) + 8 * ((d >> 2) & 1) + 4 * (d >> 3) + (d & 3); }
    return n;
}
template <bool PERMUTE>
__device__ __forceinline__ void transpose_item(const float* W, int K, int N, bf16_t* WT, LAS float* scr, int item, int lane) {
    const int nblk = N / 32, kb = item / nblk, nb = item % nblk, k0 = 64 * kb, n0 = 32 * nb;
#pragma unroll 8
    for (int i = 0; i < 32; ++i) { const int kk = 2 * i + (lane >> 5); scr[kk * 33 + (lane & 31)] = W[(size_t)(k0 + kk) * N + n0 + (lane & 31)]; }
    asm volatile("s_waitcnt lgkmcnt(0)" ::: "memory");
    const int c = lane & 7;
#pragma unroll
    for (int j = 0; j < 4; ++j) { const int n = (lane >> 3) + 8 * j; const LAS float* s = scr + (8 * c) * 33 + n;
        u32x4 o; o.x = cvtpk(s[0 * 33], s[1 * 33]); o.y = cvtpk(s[2 * 33], s[3 * 33]); o.z = cvtpk(s[4 * 33], s[5 * 33]); o.w = cvtpk(s[6 * 33], s[7 * 33]);
        const int dr = PERMUTE ? win_dest_row(n0 + n) : (n0 + n);
        *(u32x4*)(WT + (size_t)dr * K + k0 + 8 * c) = o; }
    asm volatile("s_waitcnt lgkmcnt(0)" ::: "memory");
}
struct TrItem { const float* W; bf16_t* WT; int K, N, item; bool perm; };
__device__ __forceinline__ void tr_load(const TrItem& t, f32x4 (&v)[16], int lane) {
    const int nblk = t.N / 64, kb = t.item / nblk, nb = t.item % nblk, k0 = 64 * kb, n0 = 64 * nb, r = lane >> 4, c4 = lane & 15;
    const float* wp = t.W + (size_t)(k0 + r) * t.N + n0 + 4 * c4;
#pragma unroll
    for (int i = 0; i < 16; ++i) v[i] = *(const f32x4*)(wp + (size_t)(4 * i) * t.N);
}
__device__ __forceinline__ void tr_finish(const TrItem& t, const f32x4 (&v)[16], lds_t* scr, int lane) {
    const int nblk = t.N / 64, kb = t.item / nblk, nb = t.item % nblk, k0 = 64 * kb, n0 = 64 * nb, r = lane >> 4, c4 = lane & 15;
    lds_t* wq = scr + (4 * c4) * 144 + r * 2;
#pragma unroll
    for (int i = 0; i < 16; ++i) {
        const unsigned p01 = cvtpk(v[i].x, v[i].y), p23 = cvtpk(v[i].z, v[i].w);
        *(LAS unsigned short*)(wq + 0 * 144 + i * 8) = (unsigned short)(p01 & 0xffffu); *(LAS unsigned short*)(wq + 1 * 144 + i * 8) = (unsigned short)(p01 >> 16);
        *(LAS unsigned short*)(wq + 2 * 144 + i * 8) = (unsigned short)(p23 & 0xffffu); *(LAS unsigned short*)(wq + 3 * 144 + i * 8) = (unsigned short)(p23 >> 16);
    }
    asm volatile("s_waitcnt lgkmcnt(0)" ::: "memory");
#pragma unroll
    for (int j = 0; j < 8; ++j) { const int id = lane + 64 * j, n = id >> 3, ch = id & 7;
        const u32x4 o = *(const LAS u32x4*)(scr + n * 144 + ch * 16);
        const int dr = t.perm ? win_dest_row(n0 + n) : (n0 + n);
        *(u32x4*)(t.WT + (size_t)dr * t.K + k0 + ch * 8) = o; }
    asm volatile("s_waitcnt lgkmcnt(0)" ::: "memory");
}
__device__ __forceinline__ void sincos_tab(double ang, float& c, float& s) {
    const double n = rint(ang * 0.15915494309189535);
    double r = fma(-n, 6.283185307179586, ang); r = fma(-n, 2.4492935982947064e-16, r);
    const double r2 = r * r;
    double sp = 1.0, cp = 1.0;
#pragma unroll
    for (int k = 14; k >= 1; --k) { sp = 1.0 - r2 * (1.0 / (double)((2 * k) * (2 * k + 1))) * sp; cp = 1.0 - r2 * (1.0 / (double)((2 * k - 1) * (2 * k))) * cp; }
    s = (float)(r * sp); c = (float)cp;
}
template <bool MODUL, bool OUT_F32>
__device__ __forceinline__ void norm_row(const float* xrow, const float* w, const float* sh, const float* sc, bf16_t* obf, float* of32, int lane) {
    f32x4 v[8]; float ss = 0.f;
#pragma unroll
    for (int j = 0; j < 8; ++j) { v[j] = *(const f32x4*)(xrow + 4 * lane + 256 * j); ss += (v[j].x * v[j].x + v[j].y * v[j].y) + (v[j].z * v[j].z + v[j].w * v[j].w); }
    const float rs = 1.0f / sqrtf(wave_sum(ss) * (1.0f / 2048.0f) + 1e-6f);
#pragma unroll
    for (int j = 0; j < 8; ++j) {
        const int col = 4 * lane + 256 * j;
        f32x4 y = v[j] * rs * *(const f32x4*)(w + col);
        if (MODUL) y = y * (*(const f32x4*)(sc + col) + 1.0f) + *(const f32x4*)(sh + col);
        if (OUT_F32) *(f32x4*)(of32 + col) = y;
        else { u32x2 o; o.x = cvtpk(y.x, y.y); o.y = cvtpk(y.z, y.w); *(u32x2*)(obf + col) = o; }
    }
}

struct EpiProj {
    static constexpr bool PERM = true, AFTER_DRAIN = false;
    unsigned char* ws;
    __device__ __forceinline__ void operator()(const f32x4 (&acc)[2][2][4][2], const pg8::Unit& u, int wr, int wc, int fr, int fq) const {
        const int seg = u.pn >> 2, hp = (u.pn & 3) * 2, colh = 32 * wc + 8 * fq;
        const f32x2* rotr = (const f32x2*)(ws + WS_ROTR); const f32x2* rotd = (const f32x2*)(ws + WS_ROTD);
#pragma unroll
        for (int ai = 0; ai < 2; ++ai)
#pragma unroll
            for (int m = 0; m < 4; ++m) {
                const int r = u.pm * 256 + ai * 128 + wr * 64 + m * 16 + fr, pos = r & 4095, b = r >> 12;
#pragma unroll
                for (int bj = 0; bj < 2; ++bj) {
                    const int head = hp + bj;
                    f32x4 v0 = acc[ai][bj][m][0], v1 = acc[ai][bj][m][1];
                    if (seg == 0 || seg == 1) {
                        const f32x4* cs = (const f32x4*)(rotr + (size_t)pos * 64 + 16 * wc + 4 * fq);
                        const f32x4 c01 = cs[0], c23 = cs[1];
                        const f32x4 cc = {c01.x, c01.z, c23.x, c23.z}, sn = {c01.y, c01.w, c23.y, c23.w};
                        f32x4 n0 = v0 * cc - v1 * sn, n1 = v1 * cc + v0 * sn;
                        if (seg == 1) { n0 = n0 * 0.08838834764831845f; n1 = n1 * 0.08838834764831845f; }
                        v0 = n0; v1 = n1;
                    } else if (seg == 4 || seg == 5) {
                        if ((wc & 1) == 0 && fq < 2) {
                            const f32x4* cs = (const f32x4*)(rotd + (size_t)pos * 8 + 4 * fq);
                            const f32x4 c01 = cs[0], c23 = cs[1];
                            const f32x4 cc = {c01.x, c01.z, c23.x, c23.z}, sn = {c01.y, c01.w, c23.y, c23.w};
                            const f32x4 n0 = v0 * cc - v1 * sn, n1 = v1 * cc + v0 * sn;
                            v0 = n0; v1 = n1;
                        }
                        if (seg == 4) { v0 = v0 * 0.18033688011112042f; v1 = v1 * 0.18033688011112042f; }
                    }
                    u32x4 w; w.x = cvtpk(v0[0], v0[1]); w.y = cvtpk(v0[2], v0[3]); w.z = cvtpk(v1[0], v1[1]); w.w = cvtpk(v1[2], v1[3]);
                    if (seg == 0 || seg == 1 || seg == 3 || seg == 4 || seg == 5) {
                        const size_t base = seg == 0 ? WS_RQ : seg == 1 ? WS_RK : seg == 3 ? WS_RG : seg == 4 ? WS_DQ : WS_DK;
                        *(u32x4*)((bf16_t*)(ws + base) + (size_t)r * 1024 + head * 128 + colh) = w;
                    }
                    if (seg == 1 || seg == 2 || seg == 6) {
                        const size_t base = seg == 1 ? WS_RKT : seg == 2 ? WS_RVT : WS_DVT;
                        bf16_t* t = (bf16_t*)(ws + base) + ((size_t)((b * 8 + head) * 128 + colh)) * 4096 + pos;
                        t[0 * 4096] = (bf16_t)(w.x & 0xffffu); t[1 * 4096] = (bf16_t)(w.x >> 16); t[2 * 4096] = (bf16_t)(w.y & 0xffffu); t[3 * 4096] = (bf16_t)(w.y >> 16);
                        t[4 * 4096] = (bf16_t)(w.z & 0xffffu); t[5 * 4096] = (bf16_t)(w.z >> 16); t[6 * 4096] = (bf16_t)(w.w & 0xffffu); t[7 * 4096] = (bf16_t)(w.w >> 16);
                    }
                }
            }
    }
};
struct EpiRes {
    static constexpr bool PERM = false, AFTER_DRAIN = false;
    const float* base; float* out; const float* gate;
    __device__ __forceinline__ void operator()(const f32x4 (&acc)[2][2][4][2], const pg8::Unit& u, int wr, int wc, int fr, int fq) const {
        const int col0 = u.pn * 256 + wc * 32 + 4 * fq;
        const int b = (u.pm * 256) >> 12;
        f32x4 gv[2][2];
#pragma unroll
        for (int bj = 0; bj < 2; ++bj)
#pragma unroll
            for (int n = 0; n < 2; ++n) gv[bj][n] = *(const f32x4*)(gate + (size_t)b * NMOD + col0 + bj * 128 + n * 16);
#pragma unroll
        for (int ai = 0; ai < 2; ++ai)
#pragma unroll
            for (int m = 0; m < 4; ++m) {
                const size_t off = (size_t)(u.pm * 256 + ai * 128 + wr * 64 + m * 16 + fr) * DM + col0;
#pragma unroll
                for (int bj = 0; bj < 2; ++bj)
#pragma unroll
                    for (int n = 0; n < 2; ++n) { const f32x4 bs = *(const f32x4*)(base + off + bj * 128 + n * 16); *(f32x4*)(out + off + bj * 128 + n * 16) = bs + gv[bj][n] * acc[ai][bj][m][n]; }
            }
    }
};
struct EpiRelu2 {
    static constexpr bool PERM = true, AFTER_DRAIN = false;
    bf16_t* O;
    __device__ __forceinline__ void operator()(const f32x4 (&acc)[2][2][4][2], const pg8::Unit& u, int wr, int wc, int fr, int fq) const {
        const int col0 = u.pn * 256 + wc * 32 + 8 * fq;
#pragma unroll
        for (int ai = 0; ai < 2; ++ai)
#pragma unroll
            for (int m = 0; m < 4; ++m) {
                bf16_t* rowp = O + (size_t)(u.pm * 256 + ai * 128 + wr * 64 + m * 16 + fr) * FF + col0;
#pragma unroll
                for (int bj = 0; bj < 2; ++bj) {
                    f32x4 v0 = acc[ai][bj][m][0], v1 = acc[ai][bj][m][1];
#pragma unroll
                    for (int j = 0; j < 4; ++j) { const float a = fmaxf(v0[j], 0.f), c = fmaxf(v1[j], 0.f); v0[j] = a * a; v1[j] = c * c; }
                    u32x4 w; w.x = cvtpk(v0[0], v0[1]); w.y = cvtpk(v0[2], v0[3]); w.z = cvtpk(v1[0], v1[1]); w.w = cvtpk(v1[2], v1[3]);
                    *(u32x4*)(rowp + bj * 128) = w;
                }
            }
    }
};

constexpr int AT_KROW = 144, AT_KCOMP = 64 * AT_KROW, AT_VROW = 136, AT_VOFF = 2 * AT_KCOMP, AT_STAGE = AT_VOFF + 128 * AT_VROW;
constexpr int AT_XROW = 528;
__device__ __forceinline__ void attn_unit(lds_t* lds, int b, int h, int qb, const unsigned char* ws, const float* subw, float lam, bf16_t* MIX) {
    int tid_ = threadIdx.x; asm volatile("" : "+v"(tid_));
    const int tid = tid_, lane = tid & 63, wid = __builtin_amdgcn_readfirstlane(tid >> 6);
    const int c = wid >> 2, qs = wid & 3, l15 = lane & 15, quad = lane >> 4;
    const int q0 = qb * 128, NT = 2 * qb + 2;
    const bf16_t* DQ = (const bf16_t*)(ws + WS_DQ); const bf16_t* DKp = (const bf16_t*)(ws + WS_DK); const bf16_t* DVT = (const bf16_t*)(ws + WS_DVT);
    const bf16_t* kg = DKp + (size_t)(b * 4096 + (tid >> 4)) * 1024 + h * 128 + (tid & 15) * 8;
    const unsigned kl = ((tid & 15) >> 3) * AT_KCOMP + (tid >> 4) * AT_KROW + (tid & 7) * 16;
    const bf16_t* vg = DVT + (size_t)((b * 8 + h) * 128 + (tid >> 3)) * 4096 + (tid & 7) * 8;
    const unsigned vl = AT_VOFF + (tid >> 3) * AT_VROW + (tid & 7) * 16;
    u32x4 pkA[2], pvA[2], pkB[2], pvB[2];
#define AT_LOAD(t, pk, pv) do { _Pragma("unroll") for (int i_ = 0; i_ < 2; ++i_) { pk[i_] = *(const u32x4*)(kg + (size_t)((t) * 64 + 32 * i_) * 1024); pv[i_] = *(const u32x4*)(vg + (size_t)(64 * i_) * 4096 + (t) * 64); } } while (0)
#define AT_WRITE(st, pk, pv) do { _Pragma("unroll") for (int i_ = 0; i_ < 2; ++i_) { *(LAS u32x4*)(lds + (st) * AT_STAGE + kl + i_ * 32 * AT_KROW) = pk[i_]; \
        *(LAS u32x2*)(lds + (st) * AT_STAGE + vl + i_ * 64 * AT_VROW) = (u32x2){pv[i_].x, pv[i_].y}; *(LAS u32x2*)(lds + (st) * AT_STAGE + vl + i_ * 64 * AT_VROW + 8) = (u32x2){pv[i_].z, pv[i_].w}; } } while (0)
    AT_LOAD(0, pkA, pvA); AT_LOAD(1, pkB, pvB);
    const int qrow = b * 4096 + q0 + 32 * qs;
    bf16x8 qf[2][2];
#pragma unroll
    for (int qt = 0; qt < 2; ++qt)
#pragma unroll
        for (int ks = 0; ks < 2; ++ks) qf[qt][ks] = *(const bf16x8*)(DQ + (size_t)(qrow + 16 * qt + l15) * 1024 + h * 128 + c * 64 + 32 * ks + quad * 8);
    f32x4 ot[8][2];
#pragma unroll
    for (int vt = 0; vt < 8; ++vt) { ot[vt][0] = (f32x4){0.f, 0.f, 0.f, 0.f}; ot[vt][1] = (f32x4){0.f, 0.f, 0.f, 0.f}; }
    float mrow[2] = {-INFINITY, -INFINITY}, lrow[2] = {0.f, 0.f};
    AT_WRITE(0, pkA, pvA);
    __syncthreads();
#define AT_VFRAG(vt_, s_) __builtin_shufflevector(*(const LAS s16x4*)(vb + (vt_) * 16 * AT_VROW + (s_) * 64), *(const LAS s16x4*)(vb + (vt_) * 16 * AT_VROW + (s_) * 64 + 32), 0, 1, 2, 3, 4, 5, 6, 7)
#define AT_VREAD4(st_) const lds_t* vb = lds + (st_) * AT_STAGE + AT_VOFF + l15 * AT_VROW + quad * 8; bf16x8 vfr[8]; \
    _Pragma("unroll") for (int vt = 0; vt < 4; ++vt) { vfr[2 * vt] = AT_VFRAG(vt, 0); vfr[2 * vt + 1] = AT_VFRAG(vt, 1); } __builtin_amdgcn_sched_barrier(0);
#define AT_PVREST() do { _Pragma("unroll") for (int vt = 0; vt < 4; ++vt) { \
        _Pragma("unroll") for (int s = 0; s < 2; ++s) { ot[vt][0] = MFMA16(vfr[2 * vt + s], pb[0][s], ot[vt][0]); ot[vt][1] = MFMA16(vfr[2 * vt + s], pb[1][s], ot[vt][1]); } \
        vfr[2 * vt] = AT_VFRAG(vt + 4, 0); vfr[2 * vt + 1] = AT_VFRAG(vt + 4, 1); __builtin_amdgcn_sched_barrier(0); } \
    _Pragma("unroll") for (int vt = 4; vt < 8; ++vt) _Pragma("unroll") for (int s = 0; s < 2; ++s) { ot[vt][0] = MFMA16(vfr[2 * (vt - 4) + s], pb[0][s], ot[vt][0]); ot[vt][1] = MFMA16(vfr[2 * (vt - 4) + s], pb[1][s], ot[vt][1]); } } while (0)
#define AT_QK(st_) do { const lds_t* kb = lds + (st_) * AT_STAGE + c * AT_KCOMP + l15 * AT_KROW + quad * 16; \
    _Pragma("unroll") for (int kt = 0; kt < 4; ++kt) { \
        const bf16x8 k0 = *(const LAS bf16x8*)(kb + kt * 16 * AT_KROW), k1 = *(const LAS bf16x8*)(kb + kt * 16 * AT_KROW + 64); \
        _Pragma("unroll") for (int qt = 0; qt < 2; ++qt) { f32x4 z = {0.f, 0.f, 0.f, 0.f}; z = MFMA16(k0, qf[qt][0], z); sc[qt][kt] = MFMA16(k1, qf[qt][1], z); } } \
    if (kv0 + 63 > q0 + 32 * qs) { \
        _Pragma("unroll") for (int qt = 0; qt < 2; ++qt) { const int qabs = q0 + 32 * qs + 16 * qt + l15; \
            _Pragma("unroll") for (int kt = 0; kt < 4; ++kt) _Pragma("unroll") for (int j = 0; j < 4; ++j) if (kv0 + 16 * kt + 4 * quad + j > qabs) sc[qt][kt][j] = -INFINITY; } } } while (0)
#define AT_SOFTMAX() do { _Pragma("unroll") for (int qt = 0; qt < 2; ++qt) { \
        float mx = fmaxf(fmaxf(sc[qt][0][0], sc[qt][0][1]), fmaxf(sc[qt][0][2], sc[qt][0][3])); \
        _Pragma("unroll") for (int kt = 1; kt < 4; ++kt) mx = fmaxf(mx, fmaxf(fmaxf(sc[qt][kt][0], sc[qt][kt][1]), fmaxf(sc[qt][kt][2], sc[qt][kt][3]))); \
        mx = fmaxf(mx, __shfl_xor(mx, 16)); mx = fmaxf(mx, __shfl_xor(mx, 32)); \
        const float mnew = fmaxf(mrow[qt], mx); const float alpha = __builtin_amdgcn_exp2f(mrow[qt] - mnew); mrow[qt] = mnew; float rs = 0.f; \
        _Pragma("unroll") for (int kt = 0; kt < 4; ++kt) _Pragma("unroll") for (int j = 0; j < 4; ++j) { const float p = __builtin_amdgcn_exp2f(sc[qt][kt][j] - mnew); sc[qt][kt][j] = p; rs += p; } \
        lrow[qt] = lrow[qt] * alpha + rs; \
        if (__builtin_amdgcn_ballot_w64(alpha != 1.0f) != 0ull) { _Pragma("unroll") for (int vt = 0; vt < 8; ++vt) ot[vt][qt] = ot[vt][qt] * alpha; } \
        pb[qt][0] = pack8(sc[qt][0], sc[qt][1]); pb[qt][1] = pack8(sc[qt][2], sc[qt][3]); } } while (0)
    bf16x8 pb[2][2];
#pragma unroll
    for (int qt = 0; qt < 2; ++qt) { pb[qt][0] = (bf16x8){0, 0, 0, 0, 0, 0, 0, 0}; pb[qt][1] = (bf16x8){0, 0, 0, 0, 0, 0, 0, 0}; }
#define AT_BODY(t, LK, LV, WK, WV) do { const int kv0 = (t) * 64, st_ = (t) & 1; \
        if ((t) + 2 < NT) AT_LOAD((t) + 2, LK, LV); \
        if (kv0 <= q0 + 32 * qs + 31) { { f32x4 sc[2][4]; AT_QK(st_); AT_SOFTMAX(); } __builtin_amdgcn_sched_barrier(0); AT_VREAD4(st_); AT_PVREST(); } \
        if ((t) + 1 < NT) AT_WRITE(st_ ^ 1, WK, WV); \
        __syncthreads(); } while (0)
    for (int t = 0; t < NT; t += 2) {
        AT_BODY(t, pkA, pvA, pkB, pvB);
        AT_BODY(t + 1, pkB, pvB, pkA, pvA);
    }
#undef AT_BODY
#undef AT_VFRAG
#undef AT_VREAD4
#undef AT_PVREST
#undef AT_QK
#undef AT_SOFTMAX
#undef AT_LOAD
#undef AT_WRITE
    lds_t* xr = lds + qs * 32 * AT_XROW;
#pragma unroll
    for (int qt = 0; qt < 2; ++qt) {
        float l = lrow[qt]; l += __shfl_xor(l, 16); l += __shfl_xor(l, 32);
        const float inv = (c == 1 ? lam : 1.0f) / l;
#pragma unroll
        for (int vt = 0; vt < 8; ++vt) ot[vt][qt] = ot[vt][qt] * inv;
    }
    if (c == 1) {
#pragma unroll
        for (int qt = 0; qt < 2; ++qt)
#pragma unroll
            for (int vt = 0; vt < 8; ++vt) *(LAS f32x4*)(xr + (16 * qt + l15) * AT_XROW + (16 * vt + 4 * quad) * 4) = ot[vt][qt];
    }
    __syncthreads();
    if (c == 0) {
#pragma unroll
        for (int qt = 0; qt < 2; ++qt)
#pragma unroll
            for (int vt = 0; vt < 8; ++vt) ot[vt][qt] = ot[vt][qt] - *(const LAS f32x4*)(xr + (16 * qt + l15) * AT_XROW + (16 * vt + 4 * quad) * 4);
#pragma unroll
        for (int qt = 0; qt < 2; ++qt) {
            float ss = 0.f;
#pragma unroll
            for (int vt = 0; vt < 8; ++vt) ss += (ot[vt][qt].x * ot[vt][qt].x + ot[vt][qt].y * ot[vt][qt].y) + (ot[vt][qt].z * ot[vt][qt].z + ot[vt][qt].w * ot[vt][qt].w);
            ss += __shfl_xor(ss, 16); ss += __shfl_xor(ss, 32);
            const float rs = 0.8f / sqrtf(ss * (1.0f / 128.0f) + 1e-5f);
#pragma unroll
            for (int vt = 0; vt < 8; ++vt) {
                const f32x4 w = *(const f32x4*)(subw + h * 128 + 16 * vt + 4 * quad);
                const f32x4 y = ot[vt][qt] * rs * w;
                u32x2 o; o.x = cvtpk(y.x, y.y); o.y = cvtpk(y.z, y.w);
                *(LAS u32x2*)(xr + (16 * qt + l15) * AT_XROW + (16 * vt + 4 * quad) * 2) = o;
            }
        }
        asm volatile("s_waitcnt lgkmcnt(0)" ::: "memory");
#pragma unroll
        for (int i = 0; i < 8; ++i) { const int id = lane + 64 * i, row = id >> 4, ch = id & 15;
            const u32x4 v = *(const LAS u32x4*)(xr + row * AT_XROW + ch * 16);
            *(u32x4*)(MIX + (size_t)(qrow + row) * DM + 1024 + h * 128 + ch * 8) = v; }
    }
    __syncthreads();
}

constexpr size_t WS_UT = WS_X1, WS_ST = WS_X1 + 32 * MiB;
#define OPAQUE(p) asm volatile("" : "+v"(p))
__device__ __forceinline__ float ret_lg(int h) { return log2f(1.0f - exp2f((float)(-5 - h))); }
__device__ __forceinline__ void ret_u_item(int b, int h, int cn, const unsigned char* ws) {
    int tid_ = threadIdx.x; asm volatile("" : "+v"(tid_));
    const int tid = tid_, lane = tid & 63, wid = __builtin_amdgcn_readfirstlane(tid >> 6), l15 = lane & 15, quad = lane >> 4;
    const bf16_t* RKT = (const bf16_t*)(ws + WS_RKT); const bf16_t* RVT = (const bf16_t*)(ws + WS_RVT);
    const float lgx = ret_lg(h);
    const int t0 = cn * 128;
    const bf16_t* gv = RVT + (size_t)((b * 8 + h) * 128 + 16 * wid + l15) * 4096 + t0 + 8 * quad;
    const bf16_t* gk = RKT + (size_t)((b * 8 + h) * 128 + l15) * 4096 + t0 + 8 * quad;
    bf16x8 Vz[4];
#pragma unroll
    for (int ks = 0; ks < 4; ++ks) {
        const bf16x8 vf = *(const bf16x8*)(gv + 32 * ks);
        f32x4 lo, hi;
#pragma unroll
        for (int j = 0; j < 4; ++j) { lo[j] = bf2f((unsigned short)vf[j]) * __builtin_amdgcn_exp2f((float)(127 - (32 * ks + 8 * quad + j)) * lgx); hi[j] = bf2f((unsigned short)vf[4 + j]) * __builtin_amdgcn_exp2f((float)(127 - (32 * ks + 8 * quad + 4 + j)) * lgx); }
        Vz[ks] = pack8(lo, hi);
    }
    float* UT = (float*)(ws + WS_UT) + (size_t)((b * 8 + h) * 32 + cn) * 16384 + (size_t)(16 * wid + 4 * quad) * 128 + l15;
#pragma unroll
    for (int dt = 0; dt < 8; ++dt) {
        f32x4 u = {0.f, 0.f, 0.f, 0.f};
#pragma unroll
        for (int ks = 0; ks < 4; ++ks) u = MFMA16(Vz[ks], *(const bf16x8*)(gk + (size_t)(16 * dt) * 4096 + 32 * ks), u);
#pragma unroll
        for (int j = 0; j < 4; ++j) UT[j * 128 + 16 * dt] = u[j];
    }
}
__device__ __forceinline__ void ret_scan(const unsigned char* ws, int gtid, int gthreads) {
    for (int e = gtid; e < 16 * 8192; e += gthreads) {
        const int bh = e >> 13, off = (e & 8191) * 2;
        const float cd = exp2f(128.0f * ret_lg(bh & 7));
        const float* UT = (const float*)(ws + WS_UT) + (size_t)(bh * 32) * 16384 + off;
        bf16_t* ST = (bf16_t*)(ws + WS_ST) + (size_t)(bh * 32) * 16384 + off;
        f32x2 S = {0.f, 0.f};
#pragma unroll 16
        for (int c = 0; c < 32; ++c) {
            const f32x2 u = *(const f32x2*)(UT + (size_t)c * 16384);
            *(unsigned*)(ST + (size_t)c * 16384) = cvtpk(S.x, S.y);
            S = S * cd + u;
        }
    }
}
constexpr int RC_ROW = 272, RC_MAT = 128 * RC_ROW, RC_K = 0, RC_V = RC_MAT, RC_S = 2 * RC_MAT, RC_Y = 3 * RC_MAT;
__device__ __forceinline__ void ret_c_item(lds_t* lds, int b, int h, int cn, const unsigned char* ws, const float* gnw, bf16_t* MIX) {
    int tid_ = threadIdx.x; asm volatile("" : "+v"(tid_));
    const int tid = tid_, lane = tid & 63, wid = __builtin_amdgcn_readfirstlane(tid >> 6), l15 = lane & 15, quad = lane >> 4;
    const bf16_t* RQ = (const bf16_t*)(ws + WS_RQ); const bf16_t* RK = (const bf16_t*)(ws + WS_RK); const bf16_t* RVT = (const bf16_t*)(ws + WS_RVT);
    const bf16_t* RG = (const bf16_t*)(ws + WS_RG); const bf16_t* ST = (const bf16_t*)(ws + WS_ST) + (size_t)((b * 8 + h) * 32 + cn) * 16384;
    const float lgx = ret_lg(h);
    const int t0 = cn * 128, srow = tid >> 4, sch = tid & 15;
    const size_t rowq = (size_t)(b * 4096 + t0 + 16 * wid + l15);
    {
        const bf16_t* gk = RK + (size_t)(b * 4096 + t0 + srow) * 1024 + h * 128 + sch * 8;
        const bf16_t* gv = RVT + (size_t)((b * 8 + h) * 128 + srow) * 4096 + t0 + sch * 8;
        const bf16_t* gs = ST + (size_t)srow * 128 + sch * 8;
        u32x4 pre[12];
#pragma unroll
        for (int i = 0; i < 4; ++i) { pre[i] = *(const u32x4*)(gk + (size_t)(32 * i) * 1024); pre[4 + i] = *(const u32x4*)(gv + (size_t)(32 * i) * 4096); pre[8 + i] = *(const u32x4*)(gs + (size_t)(32 * i) * 128); }
        lds_t* sl = lds + srow * RC_ROW + sch * 16; OPAQUE(sl);
#pragma unroll
        for (int i = 0; i < 4; ++i) { *(LAS u32x4*)(sl + RC_K + i * 32 * RC_ROW) = pre[i]; *(LAS u32x4*)(sl + RC_V + i * 32 * RC_ROW) = pre[4 + i]; *(LAS u32x4*)(sl + RC_S + i * 32 * RC_ROW) = pre[8 + i]; }
    }
    bf16x8 qf[4];
#pragma unroll
    for (int ks = 0; ks < 4; ++ks) qf[ks] = *(const bf16x8*)(RQ + rowq * 1024 + h * 128 + 32 * ks + 8 * quad);
    u32x2 gt[8];
#pragma unroll
    for (int vt = 0; vt < 8; ++vt) gt[vt] = *(const u32x2*)(RG + rowq * 1024 + h * 128 + 16 * vt + 4 * quad);
    __syncthreads();
    const lds_t* kA = lds + RC_K + l15 * RC_ROW + quad * 16; OPAQUE(kA);
    const lds_t* vB = lds + RC_V + l15 * RC_ROW + quad * 8; OPAQUE(vB);
    const lds_t* sA = lds + RC_S + l15 * RC_ROW + quad * 16; OPAQUE(sA);
    f32x4 pt[8];
#pragma unroll
    for (int jt = 0; jt < 8; ++jt) {
        f32x4 p = {0.f, 0.f, 0.f, 0.f};
        if (jt <= wid) {
#pragma unroll
            for (int ks = 0; ks < 4; ++ks) p = MFMA16(*(const LAS bf16x8*)(kA + jt * 16 * RC_ROW + ks * 64), qf[ks], p);
#pragma unroll
            for (int j = 0; j < 4; ++j) { const int di = 16 * (wid - jt) + l15 - 4 * quad - j; p[j] = di >= 0 ? p[j] * __builtin_amdgcn_exp2f((float)di * lgx) : 0.f; }
        }
        pt[jt] = p;
    }
    bf16x8 pb[4];
#pragma unroll
    for (int k2 = 0; k2 < 4; ++k2) pb[k2] = pack8(pt[2 * k2], pt[2 * k2 + 1]);
    const float xi = __builtin_amdgcn_exp2f((float)(16 * wid + l15 + 1) * lgx);
    f32x4 ot[8];
#pragma unroll
    for (int vt = 0; vt < 8; ++vt) {
        f32x4 o = {0.f, 0.f, 0.f, 0.f};
#pragma unroll
        for (int ks = 0; ks < 4; ++ks) o = MFMA16(*(const LAS bf16x8*)(sA + vt * 16 * RC_ROW + ks * 64), qf[ks], o);
        o = o * xi;
#pragma unroll
        for (int k2 = 0; k2 < 4; ++k2) if (2 * k2 <= wid) {
            const s16x4 lo = *(const LAS s16x4*)(vB + vt * 16 * RC_ROW + k2 * 64), hi = *(const LAS s16x4*)(vB + vt * 16 * RC_ROW + k2 * 64 + 32);
            o = MFMA16(__builtin_shufflevector(lo, hi, 0, 1, 2, 3, 4, 5, 6, 7), pb[k2], o);
        }
        ot[vt] = o;
    }
    float s = 0.f, q = 0.f;
#pragma unroll
    for (int vt = 0; vt < 8; ++vt) { s += (ot[vt].x + ot[vt].y) + (ot[vt].z + ot[vt].w); q += (ot[vt].x * ot[vt].x + ot[vt].y * ot[vt].y) + (ot[vt].z * ot[vt].z + ot[vt].w * ot[vt].w); }
    s += __shfl_xor(s, 16); s += __shfl_xor(s, 32); q += __shfl_xor(q, 16); q += __shfl_xor(q, 32);
    const float mean = s * (1.0f / 128.0f), rstd = 1.0f / sqrtf(fmaxf(q * (1.0f / 128.0f) - mean * mean, 0.f) + 1e-5f);
    lds_t* yw = lds + RC_Y + wid * 16 * RC_ROW;
#pragma unroll
    for (int vt = 0; vt < 8; ++vt) {
        const f32x4 w = *(const f32x4*)(gnw + h * 128 + 16 * vt + 4 * quad);
        const float g0 = bf2f((unsigned short)(gt[vt].x & 0xffffu)), g1 = bf2f((unsigned short)(gt[vt].x >> 16)), g2 = bf2f((unsigned short)(gt[vt].y & 0xffffu)), g3 = bf2f((unsigned short)(gt[vt].y >> 16));
        f32x4 y = (ot[vt] - mean) * rstd * w;
        y.x *= g0 * __builtin_amdgcn_rcpf(1.0f + __builtin_amdgcn_exp2f(-1.4426950408889634f * g0)); y.y *= g1 * __builtin_amdgcn_rcpf(1.0f + __builtin_amdgcn_exp2f(-1.4426950408889634f * g1));
        y.z *= g2 * __builtin_amdgcn_rcpf(1.0f + __builtin_amdgcn_exp2f(-1.4426950408889634f * g2)); y.w *= g3 * __builtin_amdgcn_rcpf(1.0f + __builtin_amdgcn_exp2f(-1.4426950408889634f * g3));
        u32x2 o; o.x = cvtpk(y.x, y.y); o.y = cvtpk(y.z, y.w);
        *(LAS u32x2*)(yw + l15 * RC_ROW + (16 * vt + 4 * quad) * 2) = o;
    }
    asm volatile("s_waitcnt lgkmcnt(0)" ::: "memory");
#pragma unroll
    for (int j = 0; j < 4; ++j) { const int id = lane + 64 * j, row = id >> 4, ch = id & 15;
        const u32x4 v = *(const LAS u32x4*)(yw + row * RC_ROW + ch * 16);
        *(u32x4*)(MIX + (size_t)(b * 4096 + t0 + 16 * wid + row) * DM + h * 128 + ch * 8) = v; }
    __syncthreads();
}

#define XB_TMO      128
#define XB_XCNT(j)  (256  + 64 * (j))
#define XB_XSUB(j)  (1280 + 64 * (j))
#define XB_XGEN(j)  (2304 + 64 * (j))
#define XB_TOP      3328
#define XB_TOPGEN   3392
#define XCD_BAR_WORDS 3456
#define XB_SPIN_CAP (1u << 18)

__device__ __forceinline__ unsigned xb_ld(unsigned* p)              { return __hip_atomic_load(p, __ATOMIC_RELAXED, __HIP_MEMORY_SCOPE_AGENT); }
__device__ __forceinline__ unsigned xb_add(unsigned* p, unsigned v) { return __hip_atomic_fetch_add(p, v, __ATOMIC_RELAXED, __HIP_MEMORY_SCOPE_AGENT); }
__device__ __forceinline__ unsigned xb_xcc_id() { return (unsigned)__builtin_amdgcn_s_getreg((3 << 11) | 20) & 0xFu; }
#define XB_SPIN(cond, bar) do { unsigned _sp = 0; while (cond) { __builtin_amdgcn_s_sleep(1); \
    if ((++_sp & 255u) == 0u) { if (xb_ld(&(bar)[XB_TMO])) break; if (_sp > XB_SPIN_CAP) { atomicAdd(&(bar)[XB_TMO], 1u); break; } } } } while (0)

struct XcdBarrier {
    unsigned* bar; unsigned x;
    volatile LAS unsigned* st;
};

__device__ __forceinline__ XcdBarrier xcd_barrier_post(unsigned* bar, volatile LAS unsigned* st) {
    XcdBarrier b; b.bar = bar; b.x = xb_xcc_id(); b.st = st;
    if (threadIdx.x == 0) (void)xb_add(&bar[XB_XCNT(b.x)], 1u);
    return b;
}
__device__ __forceinline__ void xcd_barrier_complete(unsigned* bar, unsigned x, unsigned& nloc, unsigned& nx) {
    const unsigned G = gridDim.x * gridDim.y * gridDim.z;
    unsigned sum, cnt, mine, sp = 0u;
    for (;;) {
        sum = 0u; cnt = 0u; mine = 0u;
#pragma unroll
        for (unsigned j = 0; j < 16; ++j) { const unsigned c = xb_ld(&bar[XB_XCNT(j)]); sum += c; cnt += (c > 0u) ? 1u : 0u; mine = (j == x) ? c : mine; }
        if (sum == G) break;
        __builtin_amdgcn_s_sleep(1);
        if ((++sp & 255u) == 0u) { if (xb_ld(&bar[XB_TMO])) break; if (sp > XB_SPIN_CAP) { atomicAdd(&bar[XB_TMO], 1u); break; } }
    }
    nloc = mine > 0u ? mine : 1u; nx = cnt > 0u ? cnt : 1u;
}

__device__ __forceinline__ void xcd_barrier(const XcdBarrier& b) {
    asm volatile("s_waitcnt vmcnt(0)" ::: "memory");
    __syncthreads();
    if (threadIdx.x == 0) {
        unsigned* bar = b.bar;
        __builtin_amdgcn_s_waitcnt(0);
        unsigned nloc = b.st[0], nx = b.st[1];
        if (nloc == 0u) { xcd_barrier_complete(bar, b.x, nloc, nx); b.st[0] = nloc; b.st[1] = nx; }
        const unsigned old = xb_add(&bar[XB_XSUB(b.x)], 1u);
        const unsigned gen = old / nloc;
        if (old + 1u == (gen + 1u) * nloc) {
            __builtin_amdgcn_fence(__ATOMIC_RELEASE, "agent");
            asm volatile("s_waitcnt vmcnt(0)" ::: "memory");
            const unsigned og = xb_add(&bar[XB_TOP], 1u);
            const unsigned tg = og / nx;
            if (og + 1u == (tg + 1u) * nx) xb_add(&bar[XB_TOPGEN], 1u);
            else XB_SPIN(xb_ld(&bar[XB_TOPGEN]) == tg, bar);
            __builtin_amdgcn_fence(__ATOMIC_ACQUIRE, "agent");
            xb_add(&bar[XB_XGEN(b.x)], 1u);
            asm volatile("s_waitcnt vmcnt(0)" ::: "memory");
        } else {
            XB_SPIN(xb_ld(&bar[XB_XGEN(b.x)]) == gen, bar);
            __builtin_amdgcn_fence(__ATOMIC_ACQUIRE, "agent");
            asm volatile("s_waitcnt vmcnt(0)" ::: "memory");
        }
    }
    __syncthreads();
}

__global__ void __launch_bounds__(NTHREADS, 2) fwd_megakernel(Args a) {
    extern __shared__ __attribute__((aligned(16))) unsigned char lds_raw[];
    cg::grid_group grid = cg::this_grid();
    lds_t* lds = (lds_t*)lds_raw;
#define PHASE_IDS int t__ = threadIdx.x; asm volatile("" : "+v"(t__)); const int tid = t__, lane = tid & 63, wid = __builtin_amdgcn_readfirstlane(tid >> 6), gw = bx * NWAVES + wid, NGW = G * NWAVES; (void)lane; (void)gw; (void)NGW;
    const int tid0 = threadIdx.x;
    const int G = gridDim.x, bx = blockIdx.x;
    unsigned char* ws = a.ws;
    unsigned* ctl = (unsigned*)(ws + WS_CTL);
    volatile LAS unsigned* xbst = (volatile LAS unsigned*)(lds + LDS_BYTES - 32);
    if (tid0 < 2) xbst[tid0] = 0u;
    __syncthreads();
    (void)xcd_barrier_post(ctl + 1024, xbst);
    if (gridDim.y == 0x7fffu) grid.sync();
#define GRID_BAR() do { XcdBarrier xb_; xb_.bar = (unsigned*)(a.ws + WS_CTL) + 1024; xb_.x = xb_xcc_id(); xb_.st = (volatile LAS unsigned*)(lds + LDS_BYTES - 32); xcd_barrier(xb_); } while (0)
    float* MOD = (float*)(ws + WS_MOD);
    const float* x = a.in[0];
    bf16_t* XN = (bf16_t*)(ws + WS_XN);
    bf16_t* MIX = (bf16_t*)(ws + WS_MIX);
    float* X1 = (float*)(ws + WS_X1);

#ifndef REP_P0
#define REP_P0 1
#endif
#ifndef REP_P3
#define REP_P3 1
#endif
#ifndef REP_P2
#define REP_P2 1
#endif
#ifndef REP_P6
#define REP_P6 1
#endif
    for (int rep = 0; rep < REP_P0; ++rep) {
        if (rep) GRID_BAR();
        PHASE_IDS
        const float* c = a.in[1]; const float* w_ada = a.in[2]; const float* b_ada = a.in[3];
        for (int item = bx; item < 256; item += G) {
            LAS float* sc = (LAS float*)lds; LAS f32x4* red = (LAS f32x4*)(lds + 16384);
            for (int i = tid; i < 4096; i += NTHREADS) { const float v = c[i]; sc[i] = v / (1.0f + __expf(-v)); }
            __syncthreads();
            const int c4 = tid % 12, rg = tid / 12;
            f32x4 a0 = {0.f, 0.f, 0.f, 0.f}, a1 = {0.f, 0.f, 0.f, 0.f};
            if (rg < 42) {
                const float* wp = w_ada + (size_t)rg * NMOD + item * 48 + c4 * 4;
#pragma unroll 7
                for (int i = 0; i < 49; ++i) { const int k = rg + 42 * i; if (k < 2048) { const f32x4 w = *(const f32x4*)(wp + (size_t)(42 * i) * NMOD); a0 += w * sc[k]; a1 += w * sc[2048 + k]; } }
                red[(rg * 12 + c4) * 2 + 0] = a0; red[(rg * 12 + c4) * 2 + 1] = a1;
            }
            __syncthreads();
            if (tid < 24) { const int bb = tid / 12, cc = tid % 12; f32x4 s = {0.f, 0.f, 0.f, 0.f};
                for (int r = 0; r < 42; ++r) s += red[(r * 12 + cc) * 2 + bb];
                const int n = item * 48 + cc * 4;
                *(f32x4*)(MOD + bb * NMOD + n) = s + *(const f32x4*)(b_ada + n); }
            __syncthreads();
        }
        f32x2* rotr = (f32x2*)(ws + WS_ROTR); f32x2* rotd = (f32x2*)(ws + WS_ROTD);
        for (int idx = bx * NTHREADS + tid; idx < 4096 * 64 + 4096 * 8; idx += G * NTHREADS) {
            float cc, ss;
            if (idx < 4096 * 64) { const int pos = idx >> 6, i = idx & 63; sincos_tab((double)pos * a.inv_r[i], cc, ss); rotr[idx] = (f32x2){cc, ss}; }
            else { const int e = idx - 4096 * 64, pos = e >> 3, i = e & 7; sincos_tab((double)pos * a.inv_d[i], cc, ss); rotd[e] = (f32x2){cc, ss}; }
        }
        if (bx == 0 && wid == 0) {
            const float s1 = wave_sum(a.in[8][lane] * a.in[9][lane]), s2 = wave_sum(a.in[10][lane] * a.in[11][lane]);
            if (lane == 0) MOD[2 * NMOD] = expf(s1) - expf(s2) + 0.2f;
        }
        lds_t* scr = lds + 32768 + wid * 9216;
        constexpr int I_IN = (DM / 64) * (NPROJ / 64), I_OUT = (DM / 64) * (DM / 64), I_1 = (DM / 64) * (FF / 64), I_2 = (FF / 64) * (DM / 64);
        constexpr int NITEMS = I_IN + I_OUT + I_1 + I_2;
#define TR_ITEM(dst, it_) do { int r_ = (it_); \
            if (r_ < I_IN) { dst = TrItem{a.in[6], (bf16_t*)(ws + WS_WIN), DM, NPROJ, r_, true}; } \
            else if ((r_ -= I_IN) < I_OUT) { dst = TrItem{a.in[13], (bf16_t*)(ws + WS_WOUT), DM, DM, r_, false}; } \
            else if ((r_ -= I_OUT) < I_1) { dst = TrItem{a.in[14], (bf16_t*)(ws + WS_W1), DM, FF, r_, false}; } \
            else { r_ -= I_1; dst = TrItem{a.in[15], (bf16_t*)(ws + WS_W2), FF, DM, r_, false}; } } while (0)
        if (gw < NITEMS) {
            TrItem cur, nxt; f32x4 va[16], vb[16];
            TR_ITEM(cur, gw); tr_load(cur, va, lane);
            for (int it0 = gw; it0 < NITEMS; it0 += 2 * NGW) {
                const bool h1 = it0 + NGW < NITEMS, h2 = it0 + 2 * NGW < NITEMS;
                if (h1) { TR_ITEM(nxt, it0 + NGW); tr_load(nxt, vb, lane); }
                tr_finish(cur, va, scr, lane);
                if (h1) { if (h2) { TR_ITEM(cur, it0 + 2 * NGW); tr_load(cur, va, lane); } tr_finish(nxt, vb, scr, lane); }
            }
        }
#undef TR_ITEM
    }
    GRID_BAR();
    { PHASE_IDS
    for (int m = gw; m < M; m += NGW) { const int b = m >> 12;
        norm_row<true, false>(x + (size_t)m * DM, a.in[4], MOD + b * NMOD + 0 * DM, MOD + b * NMOD + 1 * DM, XN + (size_t)m * DM, nullptr, lane); } }
    GRID_BAR();
    for (int rep = 0; rep < REP_P2; ++rep) {
        if (rep) GRID_BAR();
        pg8::Gemm g{XN, (const bf16_t*)(ws + WS_WIN), M, NPROJ, DM}; pg8::StaticOrder S; S.init(M, NPROJ, G, bx);
        EpiProj E{ws};
        pg8::gemm_phase<EpiProj, pg8::StaticOrder, true, true>(lds, g, S, E);
    }
    GRID_BAR();
    for (int rep = 0; rep < REP_P3; ++rep) {
        if (rep) GRID_BAR();
        PHASE_IDS
        const float lam = __hip_atomic_load(MOD + 2 * NMOD, __ATOMIC_RELAXED, __HIP_MEMORY_SCOPE_AGENT);
        LAS int* qword = (LAS int*)(lds + LDS_BYTES - 64);
        for (;;) {
            if (tid == 0) *qword = (int)atomicAdd(ctl + 64 + 256 * rep, 1u);
            __syncthreads();
            const int idx = *qword;
            __syncthreads();
            if (idx >= 512 + 512) break;
            if (idx < 512) { const int qb = 31 - (idx >> 4), bh = idx & 15; attn_unit(lds, bh >> 3, bh & 7, qb, ws, a.in[12], lam, MIX); }
            else { const int u = idx - 512; ret_u_item(u >> 8, (u >> 5) & 7, u & 31, ws); }
        }
#ifdef PROBE_ATT
        for (;;) {
            if (tid == 0) *qword = (int)atomicAdd(ctl + 64 + 512, 1u);
            __syncthreads();
            const int idx = *qword;
            __syncthreads();
            if (idx >= 512) break;
            { const int qb = 31 - (idx >> 4), bh = idx & 15; attn_unit(lds, bh >> 3, bh & 7, qb, ws, a.in[12], lam, MIX); }
        }
#endif
#ifdef PROBE_RET
        GRID_BAR();
        for (int u = bx; u < 512; u += G) ret_u_item(u >> 8, (u >> 5) & 7, u & 31, ws);
        GRID_BAR();
        ret_scan(ws, bx * NTHREADS + tid, G * NTHREADS);
        GRID_BAR();
        for (int u = bx; u < 512; u += G) ret_c_item(lds, u >> 8, (u >> 5) & 7, u & 31, ws, a.in[7], MIX);
        for (int u = bx; u < 512; u += G) ret_u_item(u >> 8, (u >> 5) & 7, u & 31, ws);
#endif
        GRID_BAR();
        ret_scan(ws, bx * NTHREADS + tid, G * NTHREADS);
        GRID_BAR();
        for (int u = bx; u < 512; u += G) ret_c_item(lds, u >> 8, (u >> 5) & 7, u & 31, ws, a.in[7], MIX);
    }
    GRID_BAR();
    {
        pg8::Gemm g{MIX, (const bf16_t*)(ws + WS_WOUT), M, DM, DM}; pg8::StaticOrder S; S.init(M, DM, G, bx);
        EpiRes E{x, X1, MOD + 2 * DM};
        pg8::gemm_phase<EpiRes, pg8::StaticOrder, true, true>(lds, g, S, E);
    }
    GRID_BAR();
    { PHASE_IDS
    for (int m = gw; m < M; m += NGW) { const int b = m >> 12;
        norm_row<true, false>(X1 + (size_t)m * DM, a.in[5], MOD + b * NMOD + 3 * DM, MOD + b * NMOD + 4 * DM, XN + (size_t)m * DM, nullptr, lane); } }
    GRID_BAR();
    for (int rep = 0; rep < REP_P6; ++rep) {
        if (rep) GRID_BAR();
        pg8::Gemm g{XN, (const bf16_t*)(ws + WS_W1), M, FF, DM}; pg8::StaticOrder S; S.init(M, FF, G, bx);
        EpiRelu2 E{(bf16_t*)(ws + WS_U)};
        pg8::gemm_phase<EpiRelu2, pg8::StaticOrder, true, true>(lds, g, S, E);
    }
    GRID_BAR();
    {
        pg8::Gemm g{(const bf16_t*)(ws + WS_U), (const bf16_t*)(ws + WS_W2), M, DM, FF}; pg8::StaticOrder S; S.init(M, DM, G, bx);
        EpiRes E{X1, a.out, MOD + 5 * DM};
        pg8::gemm_phase<EpiRes, pg8::StaticOrder, true, true>(lds, g, S, E);
    }
    GRID_BAR();
    PHASE_IDS
    for (int m = gw; m < M; m += NGW) norm_row<false, true>(a.out + (size_t)m * DM, a.in[16], nullptr, nullptr, nullptr, a.out + (size_t)m * DM, lane);
}

extern "C" void kernel_launch(void* const* d_in, const int* in_sizes, int n_in, void* d_out, int out_size, void* d_ws, size_t ws_size, hipStream_t stream) {
    static int grid = 0;
    if (grid == 0) {
        if (n_in != 17 || in_sizes[0] != M * DM || out_size != M * DM || ws_size < WS_END) { fprintf(stderr, "kernel_launch: unexpected shapes (n_in %d, in0 %d, out %d, ws %zu)\n", n_in, n_in > 0 ? in_sizes[0] : -1, out_size, ws_size); grid = -1; return; }
        int dev = 0, cus = 0, per_cu = 0;
        if (hipGetDevice(&dev) != hipSuccess || hipDeviceGetAttribute(&cus, hipDeviceAttributeMultiprocessorCount, dev) != hipSuccess) { grid = -1; return; }
        if (hipFuncSetAttribute((const void*)fwd_megakernel, hipFuncAttributeMaxDynamicSharedMemorySize, LDS_BYTES) != hipSuccess) { fprintf(stderr, "kernel_launch: hipFuncSetAttribute failed\n"); grid = -1; return; }
        if (hipOccupancyMaxActiveBlocksPerMultiprocessor(&per_cu, (const void*)fwd_megakernel, NTHREADS, LDS_BYTES) != hipSuccess || per_cu < 1) { fprintf(stderr, "kernel_launch: occupancy query says %d blocks per CU\n", per_cu); (void)hipGetLastError(); grid = -1; return; }
        grid = cus;
    }
    if (grid < 0) return;
    (void)hipMemsetAsync((char*)d_ws + WS_CTL, 0, CTL_ZERO_BYTES, stream);
    Args a{};
    for (int i = 0; i < 17; ++i) a.in[i] = (const float*)d_in[i];
    a.out = (float*)d_out; a.ws = (unsigned char*)d_ws;
    for (int i = 0; i < 64; ++i) a.inv_r[i] = pow(10000.0, -(double)(2 * i) / 128.0);
    for (int i = 0; i < 8; ++i) a.inv_d[i] = pow(500000.0, -(double)(2 * i) / 16.0);
    void* args[] = {&a};
    hipError_t e = hipLaunchCooperativeKernel((const void*)fwd_megakernel, dim3(grid), dim3(NTHREADS), args, LDS_BYTES, stream);
    if (e != hipSuccess) fprintf(stderr, "kernel_launch: cooperative launch failed: %s (grid %d)\n", hipGetErrorString(e), grid);
}
```

```cpp
#include <hip/hip_runtime.h>
#include <hip/hip_cooperative_groups.h>
#include <cstdio>
#include <cstdint>
#include <cmath>
namespace cg = cooperative_groups;
namespace pg8 {
#define PG8_LAS __attribute__((address_space(3)))
typedef unsigned short bf16_t;
typedef short bf16x8 __attribute__((ext_vector_type(8)));
typedef float f32x4 __attribute__((ext_vector_type(4)));
typedef unsigned u32x4 __attribute__((ext_vector_type(4)));
constexpr int BM = 256, BK = 64, HALF = 128, HTB = HALF * BK * 2  , STAGE_BYTES = 8 * HTB, NXCD = 8, WGM = 8;

__host__ __device__ __forceinline__ int lds_byte(int r, int c) { const int st = (r >> 4) * 2 + (c >> 5), rr = r & 15, cc = c & 31, ob = rr * 64 + cc * 2; return st * 1024 + (ob ^ (((ob >> 9) & 1) << 5)); }
__host__ __device__ __forceinline__ void stage_rc(int b, int& R, int& C) { const int st = b / 1024, sb = b % 1024, swz = sb ^ (((sb >> 9) & 1) << 5); R = (st >> 1) * 16 + swz / 64; C = (st & 1) * 32 + (swz % 64) / 2; }
__host__ __device__ __forceinline__ int perm32(int rho) { const int n = rho >> 4, i = rho & 15; return 8 * (i >> 2) + 4 * n + (i & 3); }

struct Unit { int pm, pn; };
struct Gemm { const bf16_t* A; const bf16_t* Bt; int M, N, K; };

struct StaticOrder {
    int nM, nN, nwg, G, c;
    __host__ __device__ void init(int M, int N, int G_, int c_) { nM = M / BM; nN = N / BM; nwg = nM * nN; G = G_; c = c_; }
    __host__ __device__ bool next(int i, Unit& u) const {
        const long L = (long)i * G + c; if (L >= nwg) return false;
        int wgid = (int)L; { const int q = nwg / NXCD, r = nwg % NXCD, xcd = wgid % NXCD, off = wgid / NXCD; wgid = (xcd < r ? xcd * (q + 1) : r * (q + 1) + (xcd - r) * q) + off; }
        const int nig = WGM * nN, gid = wgid / nig, fm = gid * WGM, gsz = (nM - fm) < WGM ? (nM - fm) : WGM;
        u.pm = fm + ((wgid % nig) % gsz); u.pn = (wgid % nig) / gsz; return true;
    }
    __device__ __forceinline__ void a_ready(const Unit&) const {}
    __device__ __forceinline__ void done(const Unit&) const {}
};
__device__ __forceinline__ unsigned cvt_pk_bf16(float lo, float hi) { unsigned r; asm volatile("v_cvt_pk_bf16_f32 %0, %1, %2" : "=v"(r) : "v"(lo), "v"(hi)); return r; }
template <class Epi, class Sched, bool ALIGN_EPI = false, bool SP2 = false>
__device__ __forceinline__ void gemm_phase(PG8_LAS unsigned char* lds, const Gemm g, const Sched& S, const Epi& E) {
    int tid_ = threadIdx.x; asm volatile("" : "+v"(tid_));
    const int tid = tid_, wid = __builtin_amdgcn_readfirstlane(tid >> 6), lane = tid & 63, wr = wid >> 2, wc = wid & 3, fr = lane & 15, fq = lane >> 4;
    const int K = g.K, nt = K / BK;
    unsigned voffA[2], voffB[2];
#pragma unroll
    for (int i = 0; i < 2; ++i) { int R, C; stage_rc(tid * 16 + i * 8192, R, C); const int Rb = Epi::PERM ? ((R & ~31) + perm32(R & 31)) : R;
        voffA[i] = (unsigned)(R * K + C) * 2u; voffB[i] = (unsigned)(Rb * K + C) * 2u; }
    const size_t kstep = (size_t)(BK * 2);
    const size_t hstep = (size_t)HALF * K * 2;
    const size_t tstep = 2 * hstep;
    const unsigned ldsw = (unsigned)wid * 1024u;
    const int aoff = lds_byte(wr * 64 + fr, fq * 8), boff = lds_byte(wc * 32 + fr, fq * 8);
#define PG8_SA(b, h) (((b) * 2 + (h)) * HTB)
#define PG8_SB(b, h) ((4 + (b) * 2 + (h)) * HTB)
#define PG8_STAGE(bufoff, gbase, voff) do { _Pragma("unroll") for (int _i = 0; _i < 2; ++_i) \
        __builtin_amdgcn_global_load_lds((const unsigned*)((const char*)(gbase) + (voff)[_i]), (PG8_LAS unsigned*)(lds + (bufoff) + ldsw + _i * 8192), 16, 0, 0); } while (0)
#define PG8_LDA(dst, b, h) do { _Pragma("unroll") for (int m = 0; m < 4; ++m) _Pragma("unroll") for (int k = 0; k < 2; ++k) dst[m][k] = *(const PG8_LAS bf16x8*)(lds + PG8_SA(b, h) + aoff + m * 2048 + k * 1024); } while (0)
#define PG8_LDB(dst, b, h) do { _Pragma("unroll") for (int n = 0; n < 2; ++n) _Pragma("unroll") for (int k = 0; k < 2; ++k) dst[n][k] = *(const PG8_LAS bf16x8*)(lds + PG8_SB(b, h) + boff + n * 2048 + k * 1024); } while (0)
#define PG8_MMA(ai, bj, At, Bt) do { __builtin_amdgcn_s_setprio(1); _Pragma("unroll") for (int m = 0; m < 4; ++m) _Pragma("unroll") for (int n = 0; n < 2; ++n) _Pragma("unroll") for (int k = 0; k < 2; ++k) \
        acc[ai][bj][m][n] = __builtin_amdgcn_mfma_f32_16x16x32_bf16(Bt[n][k], At[m][k], acc[ai][bj][m][n], 0, 0, 0); __builtin_amdgcn_s_setprio(0); } while (0)
#define PG8_WAIT_V(n) asm volatile("s_waitcnt vmcnt(" #n ")" ::: "memory")
#define PG8_WAIT_L(n) asm volatile("s_waitcnt lgkmcnt(" #n ")" ::: "memory")
#define PG8_BAR __builtin_amdgcn_s_barrier()
#define PG8_SCHED __builtin_amdgcn_sched_barrier(0)
    Unit cur, nxt; int ui = 0;
    if (!S.next(0, cur)) return;
    f32x4 acc[2][2][4][2];
#pragma unroll
    for (int a = 0; a < 2; ++a)
#pragma unroll
        for (int b = 0; b < 2; ++b)
#pragma unroll
            for (int m = 0; m < 4; ++m)
#pragma unroll
                for (int n = 0; n < 2; ++n) acc[a][b][m][n] = (f32x4){0.f, 0.f, 0.f, 0.f};
    bf16x8 At[4][2], B0[2][2], B1[2][2];
    const char* cA = (const char*)g.A + (size_t)cur.pm * tstep; const char* cB = (const char*)g.Bt + (size_t)cur.pn * tstep;
    S.a_ready(cur);
    if constexpr (SP2) {
        PG8_STAGE(PG8_SB(0, 0), cB, voffB); PG8_STAGE(PG8_SB(0, 1), cB + hstep, voffB); PG8_STAGE(PG8_SA(0, 0), cA, voffA); PG8_STAGE(PG8_SA(0, 1), cA + hstep, voffA);
        if (wr == 1) PG8_BAR;
        PG8_WAIT_V(2); PG8_BAR;
        PG8_STAGE(PG8_SB(1, 0), cB + kstep, voffB); PG8_STAGE(PG8_SA(1, 0), cA + kstep, voffA); PG8_STAGE(PG8_SB(1, 1), cB + hstep + kstep, voffB);
        PG8_WAIT_V(6); PG8_BAR;
    } else {
        PG8_STAGE(PG8_SB(0, 0), cB, voffB); PG8_STAGE(PG8_SA(0, 0), cA, voffA); PG8_STAGE(PG8_SB(0, 1), cB + hstep, voffB); PG8_STAGE(PG8_SA(0, 1), cA + hstep, voffA);
        if (wr == 1) PG8_BAR;
        PG8_WAIT_V(4); PG8_BAR;
        PG8_STAGE(PG8_SB(1, 0), cB + kstep, voffB); PG8_STAGE(PG8_SA(1, 0), cA + kstep, voffA); PG8_STAGE(PG8_SB(1, 1), cB + hstep + kstep, voffB);
        PG8_WAIT_V(6); PG8_BAR;
    }
    for (;;) {
        const bool has_next = S.next(ui + 1, nxt);
        const char* nA = has_next ? (const char*)g.A + (size_t)nxt.pm * tstep : cA; const char* nB = has_next ? (const char*)g.Bt + (size_t)nxt.pn * tstep : cB;
        for (int t = 0; t < nt; t += 2) {
            const bool last = (t == nt - 2);
            const char* a1 = cA + (size_t)(t + 1) * kstep;
            const char* a2 = last ? nA : cA + (size_t)(t + 2) * kstep; const char* b2 = last ? nB : cB + (size_t)(t + 2) * kstep;
            const char* a3 = a2 + kstep; const char* b3 = b2 + kstep;
            if (last && has_next) S.a_ready(nxt);
            if constexpr (SP2) {
            PG8_LDB(B0, 0, 0); PG8_LDB(B1, 0, 1); PG8_SCHED; PG8_LDA(At, 0, 0); PG8_STAGE(PG8_SA(1, 1), a1 + hstep, voffA);
            PG8_WAIT_V(8); PG8_WAIT_L(0); PG8_BAR; PG8_MMA(0, 0, At, B0); PG8_MMA(0, 1, At, B1); PG8_BAR; PG8_SCHED;
            PG8_LDA(At, 0, 1); PG8_STAGE(PG8_SB(0, 0), b2, voffB); PG8_STAGE(PG8_SB(0, 1), b2 + hstep, voffB); PG8_STAGE(PG8_SA(0, 0), a2, voffA);
            PG8_WAIT_V(8); PG8_WAIT_L(0); PG8_BAR; PG8_MMA(1, 0, At, B0); PG8_MMA(1, 1, At, B1); PG8_BAR; PG8_SCHED;
            PG8_LDB(B0, 1, 0); PG8_LDB(B1, 1, 1); PG8_SCHED; PG8_LDA(At, 1, 0); PG8_STAGE(PG8_SA(0, 1), a2 + hstep, voffA);
            PG8_WAIT_V(8); PG8_WAIT_L(0); PG8_BAR; PG8_MMA(0, 0, At, B0); PG8_MMA(0, 1, At, B1); PG8_BAR; PG8_SCHED;
            PG8_LDA(At, 1, 1); PG8_STAGE(PG8_SB(1, 0), b3, voffB); PG8_STAGE(PG8_SB(1, 1), b3 + hstep, voffB); PG8_STAGE(PG8_SA(1, 0), a3, voffA);
            PG8_WAIT_V(8); PG8_WAIT_L(0); PG8_BAR; PG8_MMA(1, 0, At, B0); PG8_MMA(1, 1, At, B1); PG8_BAR; PG8_SCHED;
            } else {
            PG8_LDB(B0, 0, 0); PG8_SCHED; PG8_LDA(At, 0, 0); PG8_STAGE(PG8_SA(1, 1), a1 + hstep, voffA);
            PG8_WAIT_L(8); PG8_BAR; PG8_WAIT_L(0); PG8_MMA(0, 0, At, B0); PG8_BAR; PG8_SCHED;
            PG8_LDB(B1, 0, 1); PG8_STAGE(PG8_SB(0, 0), b2, voffB);
            PG8_BAR; PG8_WAIT_L(0); PG8_MMA(0, 1, At, B1); PG8_BAR;
            PG8_LDA(At, 0, 1); PG8_STAGE(PG8_SA(0, 0), a2, voffA);
            PG8_BAR; PG8_WAIT_L(0); PG8_MMA(1, 0, At, B0); PG8_BAR; PG8_SCHED;
            PG8_STAGE(PG8_SB(0, 1), b2 + hstep, voffB);
            PG8_WAIT_V(6); PG8_BAR; PG8_MMA(1, 1, At, B1); PG8_BAR;
            PG8_LDB(B0, 1, 0); PG8_SCHED; PG8_LDA(At, 1, 0); PG8_STAGE(PG8_SA(0, 1), a2 + hstep, voffA);
            PG8_WAIT_L(8); PG8_BAR; PG8_WAIT_L(0); PG8_MMA(0, 0, At, B0); PG8_BAR; PG8_SCHED;
            PG8_LDB(B1, 1, 1); PG8_STAGE(PG8_SB(1, 0), b3, voffB);
            PG8_BAR; PG8_WAIT_L(0); PG8_MMA(0, 1, At, B1); PG8_BAR;
            PG8_LDA(At, 1, 1); PG8_STAGE(PG8_SA(1, 0), a3, voffA);
            PG8_BAR; PG8_WAIT_L(0); PG8_MMA(1, 0, At, B0); PG8_BAR; PG8_SCHED;
            PG8_STAGE(PG8_SB(1, 1), b3 + hstep, voffB);
            PG8_WAIT_V(6); PG8_BAR; PG8_MMA(1, 1, At, B1); PG8_BAR;
            }
        }
        if constexpr (ALIGN_EPI) { if (wr == 0) PG8_BAR; }
        if constexpr (!Epi::AFTER_DRAIN) { E(acc, cur, wr, wc, fr, fq); S.done(cur); }
        if (!has_next) break;
#pragma unroll
        for (int a = 0; a < 2; ++a)
#pragma unroll
            for (int b = 0; b < 2; ++b)
#pragma unroll
                for (int m = 0; m < 4; ++m)
#pragma unroll
                    for (int n = 0; n < 2; ++n) acc[a][b][m][n] = (f32x4){0.f, 0.f, 0.f, 0.f};
        cur = nxt; cA = nA; cB = nB; ++ui;
        if constexpr (ALIGN_EPI) { if (wr == 1) PG8_BAR; }
    }
    PG8_WAIT_V(0);
    if constexpr (!ALIGN_EPI) { if (wr == 0) PG8_BAR; }
    PG8_BAR;
    if constexpr (Epi::AFTER_DRAIN) { E.fused(acc, cur, wr, wc, fr, fq, lds, wid, lane); S.done(cur); }
#undef PG8_SA
#undef PG8_SB
#undef PG8_STAGE
#undef PG8_LDA
#undef PG8_LDB
#undef PG8_MMA
#undef PG8_WAIT_V
#undef PG8_WAIT_L
#undef PG8_BAR
#undef PG8_SCHED
}
}

#define LAS __attribute__((address_space(3)))
typedef unsigned short bf16_t;
typedef short bf16x8 __attribute__((ext_vector_type(8)));
typedef short s16x4 __attribute__((ext_vector_type(4)));
typedef float f32x4 __attribute__((ext_vector_type(4)));
typedef float f32x2 __attribute__((ext_vector_type(2)));
typedef unsigned u32x4 __attribute__((ext_vector_type(4)));
typedef unsigned u32x2 __attribute__((ext_vector_type(2)));
typedef __bf16 bf16x2_t __attribute__((ext_vector_type(2)));
typedef LAS unsigned char lds_t;

constexpr int BATCH = 2, SEQ = 4096, DM = 2048, M = BATCH * SEQ, NPROJ = 7168, FF = 8192, NMOD = 6 * DM;
constexpr int NTHREADS = 512, NWAVES = 8;
constexpr size_t MiB = 1u << 20;
constexpr size_t WS_CTL = 0, CTL_ZERO_BYTES = 65536;
constexpr size_t WS_MOD = 1 * MiB;
constexpr size_t WS_ROTR = 2 * MiB;
constexpr size_t WS_ROTD = 4 * MiB;
constexpr size_t WS_WIN = 5 * MiB;
constexpr size_t WS_WOUT = 33 * MiB;
constexpr size_t WS_W1 = 41 * MiB;
constexpr size_t WS_W2 = 73 * MiB;
constexpr size_t WS_XN = 105 * MiB;
constexpr size_t WS_RQ = 137 * MiB, WS_RK = 153 * MiB, WS_RKT = 169 * MiB, WS_RVT = 185 * MiB, WS_RG = 201 * MiB, WS_DQ = 217 * MiB, WS_DK = 233 * MiB, WS_DVT = 249 * MiB;
constexpr size_t WS_U = 137 * MiB;
constexpr size_t WS_MIX = 265 * MiB;
constexpr size_t WS_X1 = 297 * MiB;
constexpr size_t WS_END = 361 * MiB;
constexpr int LDS_BYTES = 149504;

__device__ __forceinline__ unsigned cvtpk(float lo, float hi) { f32x2 v = {lo, hi}; bf16x2_t b = __builtin_convertvector(v, bf16x2_t); return __builtin_bit_cast(unsigned, b); }
__device__ __forceinline__ unsigned short f2bf(float f) { return (unsigned short)(cvtpk(f, 0.f) & 0xffffu); }
__device__ __forceinline__ float bf2f(unsigned short b) { return __builtin_bit_cast(float, (unsigned)b << 16); }
__device__ __forceinline__ bf16x8 pack8(f32x4 a, f32x4 b) { u32x4 r; r.x = cvtpk(a[0], a[1]); r.y = cvtpk(a[2], a[3]); r.z = cvtpk(b[0], b[1]); r.w = cvtpk(b[2], b[3]); return __builtin_bit_cast(bf16x8, r); }
__device__ __forceinline__ float wave_sum(float v) {
#pragma unroll
    for (int o = 1; o < 64; o <<= 1) v += __shfl_xor(v, o);
    return v;
}
#define MFMA16(a, b, c) __builtin_amdgcn_mfma_f32_16x16x32_bf16((a), (b), (c), 0, 0, 0)

struct Args {
    const float* in[17]; float* out; unsigned char* ws;
    double inv_r[64]; double inv_d[8];
};

__device__ __forceinline__ int win_dest_row(int n) {
    if (n < 2048) { const int d = n & 127; return (n & ~127) + 32 * ((d >> 4) & 3) + 8 * ((d >> 2) & 3) + 4 * (d >> 6) + (d & 3); }
    if (n >= 4096 && n < 6144) { const int d = n & 63; if (d < 16) return (n & ~63) + 8 * ((d >> 2) & 1) + 4 * (d >> 3) + (d & 3); }
    return n;
}
template <bool PERMUTE>
__device__ __forceinline__ void transpose_item(const float* W, int K, int N, bf16_t* WT, LAS float* scr, int item, int lane) {
    const int nblk = N / 32, kb = item / nblk, nb = item % nblk, k0 = 64 * kb, n0 = 32 * nb;
#pragma unroll 8
    for (int i = 0; i < 32; ++i) { const int kk = 2 * i + (lane >> 5); scr[kk * 33 + (lane & 31)] = W[(size_t)(k0 + kk) * N + n0 + (lane & 31)]; }
    asm volatile("s_waitcnt lgkmcnt(0)" ::: "memory");
    const int c = lane & 7;
#pragma unroll
    for (int j = 0; j < 4; ++j) { const int n = (lane >> 3) + 8 * j; const LAS float* s = scr + (8 * c) * 33 + n;
        u32x4 o; o.x = cvtpk(s[0 * 33], s[1 * 33]); o.y = cvtpk(s[2 * 33], s[3 * 33]); o.z = cvtpk(s[4 * 33], s[5 * 33]); o.w = cvtpk(s[6 * 33], s[7 * 33]);
        const int dr = PERMUTE ? win_dest_row(n0 + n) : (n0 + n);
        *(u32x4*)(WT + (size_t)dr * K + k0 + 8 * c) = o; }
    asm volatile("s_waitcnt lgkmcnt(0)" ::: "memory");
}
struct TrItem { const float* W; bf16_t* WT; int K, N, item; bool perm; };
__device__ __forceinline__ void tr_load(const TrItem& t, f32x4 (&v)[16], int lane) {
    const int nblk = t.N / 64, kb = t.item / nblk, nb = t.item % nblk, k0 = 64 * kb, n0 = 64 * nb, r = lane >> 4, c4 = lane & 15;
    const float* wp = t.W + (size_t)(k0 + r) * t.N + n0 + 4 * c4;
#pragma unroll
    for (int i = 0; i < 16; ++i) v[i] = *(const f32x4*)(wp + (size_t)(4 * i) * t.N);
}
__device__ __forceinline__ void tr_finish(const TrItem& t, const f32x4 (&v)[16], lds_t* scr, int lane) {
    const int nblk = t.N / 64, kb = t.item / nblk, nb = t.item % nblk, k0 = 64 * kb, n0 = 64 * nb, r = lane >> 4, c4 = lane & 15;
    lds_t* wq = scr + (4 * c4) * 144 + r * 2;
#pragma unroll
    for (int i = 0; i < 16; ++i) {
        const unsigned p01 = cvtpk(v[i].x, v[i].y), p23 = cvtpk(v[i].z, v[i].w);
        *(LAS unsigned short*)(wq + 0 * 144 + i * 8) = (unsigned short)(p01 & 0xffffu); *(LAS unsigned short*)(wq + 1 * 144 + i * 8) = (unsigned short)(p01 >> 16);
        *(LAS unsigned short*)(wq + 2 * 144 + i * 8) = (unsigned short)(p23 & 0xffffu); *(LAS unsigned short*)(wq + 3 * 144 + i * 8) = (unsigned short)(p23 >> 16);
    }
    asm volatile("s_waitcnt lgkmcnt(0)" ::: "memory");
#pragma unroll
    for (int j = 0; j < 8; ++j) { const int id = lane + 64 * j, n = id >> 3, ch = id & 7;
        const u32x4 o = *(const LAS u32x4*)(scr + n * 144 + ch * 16);
        const int dr = t.perm ? win_dest_row(n0 + n) : (n0 + n);
        *(u32x4*)(t.WT + (size_t)dr * t.K + k0 + ch * 8) = o; }
    asm volatile("s_waitcnt lgkmcnt(0)" ::: "memory");
}
__device__ __forceinline__ void sincos_tab(double ang, float& c, float& s) {
    const double n = rint(ang * 0.15915494309189535);
    double r = fma(-n, 6.283185307179586, ang); r = fma(-n, 2.4492935982947064e-16, r);
    const double r2 = r * r;
    double sp = 1.0, cp = 1.0;
#pragma unroll
    for (int k = 14; k >= 1; --k) { sp = 1.0 - r2 * (1.0 / (double)((2 * k) * (2 * k + 1))) * sp; cp = 1.0 - r2 * (1.0 / (double)((2 * k - 1) * (2 * k))) * cp; }
    s = (float)(r * sp); c = (float)cp;
}
template <bool MODUL, bool OUT_F32>
__device__ __forceinline__ void norm_row(const float* xrow, const float* w, const float* sh, const float* sc, bf16_t* obf, float* of32, int lane) {
    f32x4 v[8]; float ss = 0.f;
#pragma unroll
    for (int j = 0; j < 8; ++j) { v[j] = *(const f32x4*)(xrow + 4 * lane + 256 * j); ss += (v[j].x * v[j].x + v[j].y * v[j].y) + (v[j].z * v[j].z + v[j].w * v[j].w); }
    const float rs = 1.0f / sqrtf(wave_sum(ss) * (1.0f / 2048.0f) + 1e-6f);
#pragma unroll
    for (int j = 0; j < 8; ++j) {
        const int col = 4 * lane + 256 * j;
        f32x4 y = v[j] * rs * *(const f32x4*)(w + col);
        if (MODUL) y = y * (*(const f32x4*)(sc + col) + 1.0f) + *(const f32x4*)(sh + col);
        if (OUT_F32) *(f32x4*)(of32 + col) = y;
        else { u32x2 o; o.x = cvtpk(y.x, y.y); o.y = cvtpk(y.z, y.w); *(u32x2*)(obf + col) = o; }
    }
}

struct EpiProj {
    static constexpr bool PERM = true, AFTER_DRAIN = false;
    unsigned char* ws;
    __device__ __forceinline__ void operator()(const f32x4 (&acc)[2][2][4][2], const pg8::Unit& u, int wr, int wc, int fr, int fq) const {
        const int seg = u.pn >> 2, hp = (u.pn & 3) * 2, colh = 32 * wc + 8 * fq;
        const f32x2* rotr = (const f32x2*)(ws + WS_ROTR); const f32x2* rotd = (const f32x2*)(ws + WS_ROTD);
#pragma unroll
        for (int ai = 0; ai < 2; ++ai)
#pragma unroll
            for (int m = 0; m < 4; ++m) {
                const int r = u.pm * 256 + ai * 128 + wr * 64 + m * 16 + fr, pos = r & 4095, b = r >> 12;
#pragma unroll
                for (int bj = 0; bj < 2; ++bj) {
                    const int head = hp + bj;
                    f32x4 v0 = acc[ai][bj][m][0], v1 = acc[ai][bj][m][1];
                    if (seg == 0 || seg == 1) {
                        const f32x4* cs = (const f32x4*)(rotr + (size_t)pos * 64 + 16 * wc + 4 * fq);
                        const f32x4 c01 = cs[0], c23 = cs[1];
                        const f32x4 cc = {c01.x, c01.z, c23.x, c23.z}, sn = {c01.y, c01.w, c23.y, c23.w};
                        f32x4 n0 = v0 * cc - v1 * sn, n1 = v1 * cc + v0 * sn;
                        if (seg == 1) { n0 = n0 * 0.08838834764831845f; n1 = n1 * 0.08838834764831845f; }
                        v0 = n0; v1 = n1;
                    } else if (seg == 4 || seg == 5) {
                        if ((wc & 1) == 0 && fq < 2) {
                            const f32x4* cs = (const f32x4*)(rotd + (size_t)pos * 8 + 4 * fq);
                            const f32x4 c01 = cs[0], c23 = cs[1];
                            const f32x4 cc = {c01.x, c01.z, c23.x, c23.z}, sn = {c01.y, c01.w, c23.y, c23.w};
                            const f32x4 n0 = v0 * cc - v1 * sn, n1 = v1 * cc + v0 * sn;
                            v0 = n0; v1 = n1;
                        }
                        if (seg == 4) { v0 = v0 * 0.18033688011112042f; v1 = v1 * 0.18033688011112042f; }
                    }
                    u32x4 w; w.x = cvtpk(v0[0], v0[1]); w.y = cvtpk(v0[2], v0[3]); w.z = cvtpk(v1[0], v1[1]); w.w = cvtpk(v1[2], v1[3]);
                    if (seg == 0 || seg == 1 || seg == 3 || seg == 4 || seg == 5) {
                        const size_t base = seg == 0 ? WS_RQ : seg == 1 ? WS_RK : seg == 3 ? WS_RG : seg == 4 ? WS_DQ : WS_DK;
                        *(u32x4*)((bf16_t*)(ws + base) + (size_t)r * 1024 + head * 128 + colh) = w;
                    }
                    if (seg == 1 || seg == 2 || seg == 6) {
                        const size_t base = seg == 1 ? WS_RKT : seg == 2 ? WS_RVT : WS_DVT;
                        bf16_t* t = (bf16_t*)(ws + base) + ((size_t)((b * 8 + head) * 128 + colh)) * 4096 + pos;
                        t[0 * 4096] = (bf16_t)(w.x & 0xffffu); t[1 * 4096] = (bf16_t)(w.x >> 16); t[2 * 4096] = (bf16_t)(w.y & 0xffffu); t[3 * 4096] = (bf16_t)(w.y >> 16);
                        t[4 * 4096] = (bf16_t)(w.z & 0xffffu); t[5 * 4096] = (bf16_t)(w.z >> 16); t[6 * 4096] = (bf16_t)(w.w & 0xffffu); t[7 * 4096] = (bf16_t)(w.w >> 16);
                    }
                }
            }
    }
};
struct EpiRes {
    static constexpr bool PERM = false, AFTER_DRAIN = false;
    const float* base; float* out; const float* gate;
    __device__ __forceinline__ void operator()(const f32x4 (&acc)[2][2][4][2], const pg8::Unit& u, int wr, int wc, int fr, int fq) const {
        const int col0 = u.pn * 256 + wc * 32 + 4 * fq;
        const int b = (u.pm * 256) >> 12;
        f32x4 gv[2][2];
#pragma unroll
        for (int bj = 0; bj < 2; ++bj)
#pragma unroll
            for (int n = 0; n < 2; ++n) gv[bj][n] = *(const f32x4*)(gate + (size_t)b * NMOD + col0 + bj * 128 + n * 16);
#pragma unroll
        for (int ai = 0; ai < 2; ++ai)
#pragma unroll
            for (int m = 0; m < 4; ++m) {
                const size_t off = (size_t)(u.pm * 256 + ai * 128 + wr * 64 + m * 16 + fr) * DM + col0;
#pragma unroll
                for (int bj = 0; bj < 2; ++bj)
#pragma unroll
                    for (int n = 0; n < 2; ++n) { const f32x4 bs = *(const f32x4*)(base + off + bj * 128 + n * 16); *(f32x4*)(out + off + bj * 128 + n * 16) = bs + gv[bj][n] * acc[ai][bj][m][n]; }
            }
    }
};
struct EpiRelu2 {
    static constexpr bool PERM = true, AFTER_DRAIN = false;
    bf16_t* O;
    __device__ __forceinline__ void operator()(const f32x4 (&acc)[2][2][4][2], const pg8::Unit& u, int wr, int wc, int fr, int fq) const {
        const int col0 = u.pn * 256 + wc * 32 + 8 * fq;
#pragma unroll
        for (int ai = 0; ai < 2; ++ai)
#pragma unroll
            for (int m = 0; m < 4; ++m) {
                bf16_t* rowp = O + (size_t)(u.pm * 256 + ai * 128 + wr * 64 + m * 16 + fr) * FF + col0;
#pragma unroll
                for (int bj = 0; bj < 2; ++bj) {
                    f32x4 v0 = acc[ai][bj][m][0], v1 = acc[ai][bj][m][1];
#pragma unroll
                    for (int j = 0; j < 4; ++j) { const float a = fmaxf(v0[j], 0.f), c = fmaxf(v1[j], 0.f); v0[j] = a * a; v1[j] = c * c; }
                    u32x4 w; w.x = cvtpk(v0[0], v0[1]); w.y = cvtpk(v0[2], v0[3]); w.z = cvtpk(v1[0], v1[1]); w.w = cvtpk(v1[2], v1[3]);
                    *(u32x4*)(rowp + bj * 128) = w;
                }
            }
    }
};

constexpr int AT_KROW = 144, AT_KCOMP = 64 * AT_KROW, AT_VROW = 136, AT_VOFF = 2 * AT_KCOMP, AT_STAGE = AT_VOFF + 128 * AT_VROW;
constexpr int AT_XROW = 528;
__device__ __forceinline__ void attn_unit(lds_t* lds, int b, int h, int qb, const unsigned char* ws, const float* subw, float lam, bf16_t* MIX) {
    int tid_ = threadIdx.x; asm volatile("" : "+v"(tid_));
    const int tid = tid_, lane = tid & 63, wid = __builtin_amdgcn_readfirstlane(tid >> 6);
    const int c = wid >> 2, qs = wid & 3, l15 = lane & 15, quad = lane >> 4;
    const int q0 = qb * 128, NT = 2 * qb + 2;
    const bf16_t* DQ = (const bf16_t*)(ws + WS_DQ); const bf16_t* DKp = (const bf16_t*)(ws + WS_DK); const bf16_t* DVT = (const bf16_t*)(ws + WS_DVT);
    const bf16_t* kg = DKp + (size_t)(b * 4096 + (tid >> 4)) * 1024 + h * 128 + (tid & 15) * 8;
    const unsigned kl = ((tid & 15) >> 3) * AT_KCOMP + (tid >> 4) * AT_KROW + (tid & 7) * 16;
    const bf16_t* vg = DVT + (size_t)((b * 8 + h) * 128 + (tid >> 3)) * 4096 + (tid & 7) * 8;
    const unsigned vl = AT_VOFF + (tid >> 3) * AT_VROW + (tid & 7) * 16;
    u32x4 pkA[2], pvA[2], pkB[2], pvB[2];
#define AT_LOAD(t, pk, pv) do { _Pragma("unroll") for (int i_ = 0; i_ < 2; ++i_) { pk[i_] = *(const u32x4*)(kg + (size_t)((t) * 64 + 32 * i_) * 1024); pv[i_] = *(const u32x4*)(vg + (size_t)(64 * i_) * 4096 + (t) * 64); } } while (0)
#define AT_WRITE(st, pk, pv) do { _Pragma("unroll") for (int i_ = 0; i_ < 2; ++i_) { *(LAS u32x4*)(lds + (st) * AT_STAGE + kl + i_ * 32 * AT_KROW) = pk[i_]; \
        *(LAS u32x2*)(lds + (st) * AT_STAGE + vl + i_ * 64 * AT_VROW) = (u32x2){pv[i_].x, pv[i_].y}; *(LAS u32x2*)(lds + (st) * AT_STAGE + vl + i_ * 64 * AT_VROW + 8) = (u32x2){pv[i_].z, pv[i_].w}; } } while (0)
    AT_LOAD(0, pkA, pvA); AT_LOAD(1, pkB, pvB);
    const int qrow = b * 4096 + q0 + 32 * qs;
    bf16x8 qf[2][2];
#pragma unroll
    for (int qt = 0; qt < 2; ++qt)
#pragma unroll
        for (int ks = 0; ks < 2; ++ks) qf[qt][ks] = *(const bf16x8*)(DQ + (size_t)(qrow + 16 * qt + l15) * 1024 + h * 128 + c * 64 + 32 * ks + quad * 8);
    f32x4 ot[8][2];
#pragma unroll
    for (int vt = 0; vt < 8; ++vt) { ot[vt][0] = (f32x4){0.f, 0.f, 0.f, 0.f}; ot[vt][1] = (f32x4){0.f, 0.f, 0.f, 0.f}; }
    float mrow[2] = {-INFINITY, -INFINITY}, lrow[2] = {0.f, 0.f};
    AT_WRITE(0, pkA, pvA);
    __syncthreads();
#define AT_VFRAG(vt_, s_) __builtin_shufflevector(*(const LAS s16x4*)(vb + (vt_) * 16 * AT_VROW + (s_) * 64), *(const LAS s16x4*)(vb + (vt_) * 16 * AT_VROW + (s_) * 64 + 32), 0, 1, 2, 3, 4, 5, 6, 7)
#define AT_VREAD4(st_) const lds_t* vb = lds + (st_) * AT_STAGE + AT_VOFF + l15 * AT_VROW + quad * 8; bf16x8 vfr[8]; \
    _Pragma("unroll") for (int vt = 0; vt < 4; ++vt) { vfr[2 * vt] = AT_VFRAG(vt, 0); vfr[2 * vt + 1] = AT_VFRAG(vt, 1); } __builtin_amdgcn_sched_barrier(0);
#define AT_PVREST() do { _Pragma("unroll") for (int vt = 0; vt < 4; ++vt) { \
        _Pragma("unroll") for (int s = 0; s < 2; ++s) { ot[vt][0] = MFMA16(vfr[2 * vt + s], pb[0][s], ot[vt][0]); ot[vt][1] = MFMA16(vfr[2 * vt + s], pb[1][s], ot[vt][1]); } \
        vfr[2 * vt] = AT_VFRAG(vt + 4, 0); vfr[2 * vt + 1] = AT_VFRAG(vt + 4, 1); __builtin_amdgcn_sched_barrier(0); } \
    _Pragma("unroll") for (int vt = 4; vt < 8; ++vt) _Pragma("unroll") for (int s = 0; s < 2; ++s) { ot[vt][0] = MFMA16(vfr[2 * (vt - 4) + s], pb[0][s], ot[vt][0]); ot[vt][1] = MFMA16(vfr[2 * (vt - 4) + s], pb[1][s], ot[vt][1]); } } while (0)
#define AT_QK(st_) do { const lds_t* kb = lds + (st_) * AT_STAGE + c * AT_KCOMP + l15 * AT_KROW + quad * 16; \
    _Pragma("unroll") for (int kt = 0; kt < 4; ++kt) { \
        const bf16x8 k0 = *(const LAS bf16x8*)(kb + kt * 16 * AT_KROW), k1 = *(const LAS bf16x8*)(kb + kt * 16 * AT_KROW + 64); \
        _Pragma("unroll") for (int qt = 0; qt < 2; ++qt) { f32x4 z = {0.f, 0.f, 0.f, 0.f}; z = MFMA16(k0, qf[qt][0], z); sc[qt][kt] = MFMA16(k1, qf[qt][1], z); } } \
    if (kv0 + 63 > q0 + 32 * qs) { \
        _Pragma("unroll") for (int qt = 0; qt < 2; ++qt) { const int qabs = q0 + 32 * qs + 16 * qt + l15; \
            _Pragma("unroll") for (int kt = 0; kt < 4; ++kt) _Pragma("unroll") for (int j = 0; j < 4; ++j) if (kv0 + 16 * kt + 4 * quad + j > qabs) sc[qt][kt][j] = -INFINITY; } } } while (0)
#define AT_SOFTMAX() do { _Pragma("unroll") for (int qt = 0; qt < 2; ++qt) { \
        float mx = fmaxf(fmaxf(sc[qt][0][0], sc[qt][0][1]), fmaxf(sc[qt][0][2], sc[qt][0][3])); \
        _Pragma("unroll") for (int kt = 1; kt < 4; ++kt) mx = fmaxf(mx, fmaxf(fmaxf(sc[qt][kt][0], sc[qt][kt][1]), fmaxf(sc[qt][kt][2], sc[qt][kt][3]))); \
        mx = fmaxf(mx, __shfl_xor(mx, 16)); mx = fmaxf(mx, __shfl_xor(mx, 32)); \
        const float mnew = fmaxf(mrow[qt], mx); const float alpha = __builtin_amdgcn_exp2f(mrow[qt] - mnew); mrow[qt] = mnew; float rs = 0.f; \
        _Pragma("unroll") for (int kt = 0; kt < 4; ++kt) _Pragma("unroll") for (int j = 0; j < 4; ++j) { const float p = __builtin_amdgcn_exp2f(sc[qt][kt][j] - mnew); sc[qt][kt][j] = p; rs += p; } \
        lrow[qt] = lrow[qt] * alpha + rs; \
        if (__builtin_amdgcn_ballot_w64(alpha != 1.0f) != 0ull) { _Pragma("unroll") for (int vt = 0; vt < 8; ++vt) ot[vt][qt] = ot[vt][qt] * alpha; } \
        pb[qt][0] = pack8(sc[qt][0], sc[qt][1]); pb[qt][1] = pack8(sc[qt][2], sc[qt][3]); } } while (0)
    bf16x8 pb[2][2];
#pragma unroll
    for (int qt = 0; qt < 2; ++qt) { pb[qt][0] = (bf16x8){0, 0, 0, 0, 0, 0, 0, 0}; pb[qt][1] = (bf16x8){0, 0, 0, 0, 0, 0, 0, 0}; }
#define AT_BODY(t, LK, LV, WK, WV) do { const int kv0 = (t) * 64, st_ = (t) & 1; \
        if ((t) + 2 < NT) AT_LOAD((t) + 2, LK, LV); \
        if (kv0 <= q0 + 32 * qs + 31) { { f32x4 sc[2][4]; AT_QK(st_); AT_SOFTMAX(); } __builtin_amdgcn_sched_barrier(0); AT_VREAD4(st_); AT_PVREST(); } \
        if ((t) + 1 < NT) AT_WRITE(st_ ^ 1, WK, WV); \
        __syncthreads(); } while (0)
    for (int t = 0; t < NT; t += 2) {
        AT_BODY(t, pkA, pvA, pkB, pvB);
        AT_BODY(t + 1, pkB, pvB, pkA, pvA);
    }
#undef AT_BODY
#undef AT_VFRAG
#undef AT_VREAD4
#undef AT_PVREST
#undef AT_QK
#undef AT_SOFTMAX
#undef AT_LOAD
#undef AT_WRITE
    lds_t* xr = lds + qs * 32 * AT_XROW;
#pragma unroll
    for (int qt = 0; qt < 2; ++qt) {
        float l = lrow[qt]; l += __shfl_xor(l, 16); l += __shfl_xor(l, 32);
        const float inv = (c == 1 ? lam : 1.0f) / l;
#pragma unroll
        for (int vt = 0; vt < 8; ++vt) ot[vt][qt] = ot[vt][qt] * inv;
    }
    if (c == 1) {
#pragma unroll
        for (int qt = 0; qt < 2; ++qt)
#pragma unroll
            for (int vt = 0; vt < 8; ++vt) *(LAS f32x4*)(xr + (16 * qt + l15) * AT_XROW + (16 * vt + 4 * quad) * 4) = ot[vt][qt];
    }
    __syncthreads();
    if (c == 0) {
#pragma unroll
        for (int qt = 0; qt < 2; ++qt)
#pragma unroll
            for (int vt = 0; vt < 8; ++vt) ot[vt][qt] = ot[vt][qt] - *(const LAS f32x4*)(xr + (16 * qt + l15) * AT_XROW + (16 * vt + 4 * quad) * 4);
#pragma unroll
        for (int qt = 0; qt < 2; ++qt) {
            float ss = 0.f;
#pragma unroll
            for (int vt = 0; vt < 8; ++vt) ss += (ot[vt][qt].x * ot[vt][qt].x + ot[vt][qt].y * ot[vt][qt].y) + (ot[vt][qt].z * ot[vt][qt].z + ot[vt][qt].w * ot[vt][qt].w);
            ss += __shfl_xor(ss, 16); ss += __shfl_xor(ss, 32);
            const float rs = 0.8f / sqrtf(ss * (1.0f / 128.0f) + 1e-5f);
#pragma unroll
            for (int vt = 0; vt < 8; ++vt) {
                const f32x4 w = *(const f32x4*)(subw + h * 128 + 16 * vt + 4 * quad);
                const f32x4 y = ot[vt][qt] * rs * w;
                u32x2 o; o.x = cvtpk(y.x, y.y); o.y = cvtpk(y.z, y.w);
                *(LAS u32x2*)(xr + (16 * qt + l15) * AT_XROW + (16 * vt + 4 * quad) * 2) = o;
            }
        }
        asm volatile("s_waitcnt lgkmcnt(0)" ::: "memory");
#pragma unroll
        for (int i = 0; i < 8; ++i) { const int id = lane + 64 * i, row = id >> 4, ch = id & 15;
            const u32x4 v = *(const LAS u32x4*)(xr + row * AT_XROW + ch * 16);
            *(u32x4*)(MIX + (size_t)(qrow + row) * DM + 1024 + h * 128 + ch * 8) = v; }
    }
    __syncthreads();
}

constexpr size_t WS_UT = WS_X1, WS_ST = WS_X1 + 32 * MiB;
#define OPAQUE(p) asm volatile("" : "+v"(p))
__device__ __forceinline__ float ret_lg(int h) { return log2f(1.0f - exp2f((float)(-5 - h))); }
__device__ __forceinline__ void ret_u_item(int b, int h, int cn, const unsigned char* ws) {
    int tid_ = threadIdx.x; asm volatile("" : "+v"(tid_));
    const int tid = tid_, lane = tid & 63, wid = __builtin_amdgcn_readfirstlane(tid >> 6), l15 = lane & 15, quad = lane >> 4;
    const bf16_t* RKT = (const bf16_t*)(ws + WS_RKT); const bf16_t* RVT = (const bf16_t*)(ws + WS_RVT);
    const float lgx = ret_lg(h);
    const int t0 = cn * 128;
    const bf16_t* gv = RVT + (size_t)((b * 8 + h) * 128 + 16 * wid + l15) * 4096 + t0 + 8 * quad;
    const bf16_t* gk = RKT + (size_t)((b * 8 + h) * 128 + l15) * 4096 + t0 + 8 * quad;
    bf16x8 Vz[4];
#pragma unroll
    for (int ks = 0; ks < 4; ++ks) {
        const bf16x8 vf = *(const bf16x8*)(gv + 32 * ks);
        f32x4 lo, hi;
#pragma unroll
        for (int j = 0; j < 4; ++j) { lo[j] = bf2f((unsigned short)vf[j]) * __builtin_amdgcn_exp2f((float)(127 - (32 * ks + 8 * quad + j)) * lgx); hi[j] = bf2f((unsigned short)vf[4 + j]) * __builtin_amdgcn_exp2f((float)(127 - (32 * ks + 8 * quad + 4 + j)) * lgx); }
        Vz[ks] = pack8(lo, hi);
    }
    float* UT = (float*)(ws + WS_UT) + (size_t)((b * 8 + h) * 32 + cn) * 16384 + (size_t)(16 * wid + 4 * quad) * 128 + l15;
#pragma unroll
    for (int dt = 0; dt < 8; ++dt) {
        f32x4 u = {0.f, 0.f, 0.f, 0.f};
#pragma unroll
        for (int ks = 0; ks < 4; ++ks) u = MFMA16(Vz[ks], *(const bf16x8*)(gk + (size_t)(16 * dt) * 4096 + 32 * ks), u);
#pragma unroll
        for (int j = 0; j < 4; ++j) UT[j * 128 + 16 * dt] = u[j];
    }
}
__device__ __forceinline__ void ret_scan(const unsigned char* ws, int gtid, int gthreads) {
    for (int e = gtid; e < 16 * 8192; e += gthreads) {
        const int bh = e >> 13, off = (e & 8191) * 2;
        const float cd = exp2f(128.0f * ret_lg(bh & 7));
        const float* UT = (const float*)(ws + WS_UT) + (size_t)(bh * 32) * 16384 + off;
        bf16_t* ST = (bf16_t*)(ws + WS_ST) + (size_t)(bh * 32) * 16384 + off;
        f32x2 S = {0.f, 0.f};
#pragma unroll 16
        for (int c = 0; c < 32; ++c) {
            const f32x2 u = *(const f32x2*)(UT + (size_t)c * 16384);
            *(unsigned*)(ST + (size_t)c * 16384) = cvtpk(S.x, S.y);
            S = S * cd + u;
        }
    }
}
constexpr int RC_ROW = 272, RC_MAT = 128 * RC_ROW, RC_K = 0, RC_V = RC_MAT, RC_S = 2 * RC_MAT, RC_Y = 3 * RC_MAT;
__device__ __forceinline__ void ret_c_item(lds_t* lds, int b, int h, int cn, const unsigned char* ws, const float* gnw, bf16_t* MIX) {
    int tid_ = threadIdx.x; asm volatile("" : "+v"(tid_));
    const int tid = tid_, lane = tid & 63, wid = __builtin_amdgcn_readfirstlane(tid >> 6), l15 = lane & 15, quad = lane >> 4;
    const bf16_t* RQ = (const bf16_t*)(ws + WS_RQ); const bf16_t* RK = (const bf16_t*)(ws + WS_RK); const bf16_t* RVT = (const bf16_t*)(ws + WS_RVT);
    const bf16_t* RG = (const bf16_t*)(ws + WS_RG); const bf16_t* ST = (const bf16_t*)(ws + WS_ST) + (size_t)((b * 8 + h) * 32 + cn) * 16384;
    const float lgx = ret_lg(h);
    const int t0 = cn * 128, srow = tid >> 4, sch = tid & 15;
    const size_t rowq = (size_t)(b * 4096 + t0 + 16 * wid + l15);
    {
        const bf16_t* gk = RK + (size_t)(b * 4096 + t0 + srow) * 1024 + h * 128 + sch * 8;
        const bf16_t* gv = RVT + (size_t)((b * 8 + h) * 128 + srow) * 4096 + t0 + sch * 8;
        const bf16_t* gs = ST + (size_t)srow * 128 + sch * 8;
        u32x4 pre[12];
#pragma unroll
        for (int i = 0; i < 4; ++i) { pre[i] = *(const u32x4*)(gk + (size_t)(32 * i) * 1024); pre[4 + i] = *(const u32x4*)(gv + (size_t)(32 * i) * 4096); pre[8 + i] = *(const u32x4*)(gs + (size_t)(32 * i) * 128); }
        lds_t* sl = lds + srow * RC_ROW + sch * 16; OPAQUE(sl);
#pragma unroll
        for (int i = 0; i < 4; ++i) { *(LAS u32x4*)(sl + RC_K + i * 32 * RC_ROW) = pre[i]; *(LAS u32x4*)(sl + RC_V + i * 32 * RC_ROW) = pre[4 + i]; *(LAS u32x4*)(sl + RC_S + i * 32 * RC_ROW) = pre[8 + i]; }
    }
    bf16x8 qf[4];
#pragma unroll
    for (int ks = 0; ks < 4; ++ks) qf[ks] = *(const bf16x8*)(RQ + rowq * 1024 + h * 128 + 32 * ks + 8 * quad);
    u32x2 gt[8];
#pragma unroll
    for (int vt = 0; vt < 8; ++vt) gt[vt] = *(const u32x2*)(RG + rowq * 1024 + h * 128 + 16 * vt + 4 * quad);
    __syncthreads();
    const lds_t* kA = lds + RC_K + l15 * RC_ROW + quad * 16; OPAQUE(kA);
    const lds_t* vB = lds + RC_V + l15 * RC_ROW + quad * 8; OPAQUE(vB);
    const lds_t* sA = lds + RC_S + l15 * RC_ROW + quad * 16; OPAQUE(sA);
    f32x4 pt[8];
#pragma unroll
    for (int jt = 0; jt < 8; ++jt) {
        f32x4 p = {0.f, 0.f, 0.f, 0.f};
        if (jt <= wid) {
#pragma unroll
            for (int ks = 0; ks < 4; ++ks) p = MFMA16(*(const LAS bf16x8*)(kA + jt * 16 * RC_ROW + ks * 64), qf[ks], p);
#pragma unroll
            for (int j = 0; j < 4; ++j) { const int di = 16 * (wid - jt) + l15 - 4 * quad - j; p[j] = di >= 0 ? p[j] * __builtin_amdgcn_exp2f((float)di * lgx) : 0.f; }
        }
        pt[jt] = p;
    }
    bf16x8 pb[4];
#pragma unroll
    for (int k2 = 0; k2 < 4; ++k2) pb[k2] = pack8(pt[2 * k2], pt[2 * k2 + 1]);
    const float xi = __builtin_amdgcn_exp2f((float)(16 * wid + l15 + 1) * lgx);
    f32x4 ot[8];
#pragma unroll
    for (int vt = 0; vt < 8; ++vt) {
        f32x4 o = {0.f, 0.f, 0.f, 0.f};
#pragma unroll
        for (int ks = 0; ks < 4; ++ks) o = MFMA16(*(const LAS bf16x8*)(sA + vt * 16 * RC_ROW + ks * 64), qf[ks], o);
        o = o * xi;
#pragma unroll
        for (int k2 = 0; k2 < 4; ++k2) if (2 * k2 <= wid) {
            const s16x4 lo = *(const LAS s16x4*)(vB + vt * 16 * RC_ROW + k2 * 64), hi = *(const LAS s16x4*)(vB + vt * 16 * RC_ROW + k2 * 64 + 32);
            o = MFMA16(__builtin_shufflevector(lo, hi, 0, 1, 2, 3, 4, 5, 6, 7), pb[k2], o);
        }
        ot[vt] = o;
    }
    float s = 0.f, q = 0.f;
#pragma unroll
    for (int vt = 0; vt < 8; ++vt) { s += (ot[vt].x + ot[vt].y) + (ot[vt].z + ot[vt].w); q += (ot[vt].x * ot[vt].x + ot[vt].y * ot[vt].y) + (ot[vt].z * ot[vt].z + ot[vt].w * ot[vt].w); }
    s += __shfl_xor(s, 16); s += __shfl_xor(s, 32); q += __shfl_xor(q, 16); q += __shfl_xor(q, 32);
    const float mean = s * (1.0f / 128.0f), rstd = 1.0f / sqrtf(fmaxf(q * (1.0f / 128.0f) - mean * mean, 0.f) + 1e-5f);
    lds_t* yw = lds + RC_Y + wid * 16 * RC_ROW;
#pragma unroll
    for (int vt = 0; vt < 8; ++vt) {
        const f32x4 w = *(const f32x4*)(gnw + h * 128 + 16 * vt + 4 * quad);
        const float g0 = bf2f((unsigned short)(gt[vt].x & 0xffffu)), g1 = bf2f((unsigned short)(gt[vt].x >> 16)), g2 = bf2f((unsigned short)(gt[vt].y & 0xffffu)), g3 = bf2f((unsigned short)(gt[vt].y >> 16));
        f32x4 y = (ot[vt] - mean) * rstd * w;
        y.x *= g0 * __builtin_amdgcn_rcpf(1.0f + __builtin_amdgcn_exp2f(-1.4426950408889634f * g0)); y.y *= g1 * __builtin_amdgcn_rcpf(1.0f + __builtin_amdgcn_exp2f(-1.4426950408889634f * g1));
        y.z *= g2 * __builtin_amdgcn_rcpf(1.0f + __builtin_amdgcn_exp2f(-1.4426950408889634f * g2)); y.w *= g3 * __builtin_amdgcn_rcpf(1.0f + __builtin_amdgcn_exp2f(-1.4426950408889634f * g3));
        u32x2 o; o.x = cvtpk(y.x, y.y); o.y = cvtpk(y.z, y.w);
        *(LAS u32x2*)(yw + l15 * RC_ROW + (16 * vt + 4 * quad) * 2) = o;
    }
    asm volatile("s_waitcnt lgkmcnt(0)" ::: "memory");
#pragma unroll
    for (int j = 0; j < 4; ++j) { const int id = lane + 64 * j, row = id >> 4, ch = id & 15;
        const u32x4 v = *(const LAS u32x4*)(yw + row * RC_ROW + ch * 16);
        *(u32x4*)(MIX + (size_t)(b * 4096 + t0 + 16 * wid + row) * DM + h * 128 + ch * 8) = v; }
    __syncthreads();
}

#define XB_TMO      128
#define XB_XCNT(j)  (256  + 64 * (j))
#define XB_XSUB(j)  (1280 + 64 * (j))
#define XB_XGEN(j)  (2304 + 64 * (j))
#define XB_TOP      3328
#define XB_TOPGEN   3392
#define XCD_BAR_WORDS 3456
#define XB_SPIN_CAP (1u << 18)

__device__ __forceinline__ unsigned xb_ld(unsigned* p)              { return __hip_atomic_load(p, __ATOMIC_RELAXED, __HIP_MEMORY_SCOPE_AGENT); }
__device__ __forceinline__ unsigned xb_add(unsigned* p, unsigned v) { return __hip_atomic_fetch_add(p, v, __ATOMIC_RELAXED, __HIP_MEMORY_SCOPE_AGENT); }
__device__ __forceinline__ unsigned xb_xcc_id() { return (unsigned)__builtin_amdgcn_s_getreg((3 << 11) | 20) & 0xFu; }
#define XB_SPIN(cond, bar) do { unsigned _sp = 0; while (cond) { __builtin_amdgcn_s_sleep(1); \
    if ((++_sp & 255u) == 0u) { if (xb_ld(&(bar)[XB_TMO])) break; if (_sp > XB_SPIN_CAP) { atomicAdd(&(bar)[XB_TMO], 1u); break; } } } } while (0)

struct XcdBarrier {
    unsigned* bar; unsigned x;
    volatile LAS unsigned* st;
};

__device__ __forceinline__ XcdBarrier xcd_barrier_post(unsigned* bar, volatile LAS unsigned* st) {
    XcdBarrier b; b.bar = bar; b.x = xb_xcc_id(); b.st = st;
    if (threadIdx.x == 0) (void)xb_add(&bar[XB_XCNT(b.x)], 1u);
    return b;
}
__device__ __forceinline__ void xcd_barrier_complete(unsigned* bar, unsigned x, unsigned& nloc, unsigned& nx) {
    const unsigned G = gridDim.x * gridDim.y * gridDim.z;
    unsigned sum, cnt, mine, sp = 0u;
    for (;;) {
        sum = 0u; cnt = 0u; mine = 0u;
#pragma unroll
        for (unsigned j = 0; j < 16; ++j) { const unsigned c = xb_ld(&bar[XB_XCNT(j)]); sum += c; cnt += (c > 0u) ? 1u : 0u; mine = (j == x) ? c : mine; }
        if (sum == G) break;
        __builtin_amdgcn_s_sleep(1);
        if ((++sp & 255u) == 0u) { if (xb_ld(&bar[XB_TMO])) break; if (sp > XB_SPIN_CAP) { atomicAdd(&bar[XB_TMO], 1u); break; } }
    }
    nloc = mine > 0u ? mine : 1u; nx = cnt > 0u ? cnt : 1u;
}

__device__ __forceinline__ void xcd_barrier(const XcdBarrier& b) {
    asm volatile("s_waitcnt vmcnt(0)" ::: "memory");
    __syncthreads();
    if (threadIdx.x == 0) {
        unsigned* bar = b.bar;
        __builtin_amdgcn_s_waitcnt(0);
        unsigned nloc = b.st[0], nx = b.st[1];
        if (nloc == 0u) { xcd_barrier_complete(bar, b.x, nloc, nx); b.st[0] = nloc; b.st[1] = nx; }
        const unsigned old = xb_add(&bar[XB_XSUB(b.x)], 1u);
        const unsigned gen = old / nloc;
        if (old + 1u == (gen + 1u) * nloc) {
            __builtin_amdgcn_fence(__ATOMIC_RELEASE, "agent");
            asm volatile("s_waitcnt vmcnt(0)" ::: "memory");
            const unsigned og = xb_add(&bar[XB_TOP], 1u);
            const unsigned tg = og / nx;
            if (og + 1u == (tg + 1u) * nx) xb_add(&bar[XB_TOPGEN], 1u);
            else XB_SPIN(xb_ld(&bar[XB_TOPGEN]) == tg, bar);
            __builtin_amdgcn_fence(__ATOMIC_ACQUIRE, "agent");
            xb_add(&bar[XB_XGEN(b.x)], 1u);
            asm volatile("s_waitcnt vmcnt(0)" ::: "memory");
        } else {
            XB_SPIN(xb_ld(&bar[XB_XGEN(b.x)]) == gen, bar);
            __builtin_amdgcn_fence(__ATOMIC_ACQUIRE, "agent");
            asm volatile("s_waitcnt vmcnt(0)" ::: "memory");
        }
    }
    __syncthreads();
}

constexpr int I_IN = (DM / 64) * (NPROJ / 64), I_OUT = (DM / 64) * (DM / 64), I_1 = (DM / 64) * (FF / 64), I_2 = (FF / 64) * (DM / 64), I_ALL = I_IN + I_OUT + I_1 + I_2;
#define TR_ITEM(dst, it_) do { int r_ = (it_); \
        if (r_ < I_IN) { dst = TrItem{a.in[6], (bf16_t*)(ws + WS_WIN), DM, NPROJ, r_, true}; } \
        else if ((r_ -= I_IN) < I_OUT) { dst = TrItem{a.in[13], (bf16_t*)(ws + WS_WOUT), DM, DM, r_, false}; } \
        else if ((r_ -= I_OUT) < I_1) { dst = TrItem{a.in[14], (bf16_t*)(ws + WS_W1), DM, FF, r_, false}; } \
        else { r_ -= I_1; dst = TrItem{a.in[15], (bf16_t*)(ws + WS_W2), FF, DM, r_, false}; } } while (0)
#define TR_RUN(lo_, hi_, w_, nw_) do { lds_t* scr = lds + 32768 + wid * 9216; const int first_ = (lo_) + (w_), step_ = (nw_), end_ = (hi_); \
        if (first_ < end_) { TrItem cur, nxt; f32x4 va[16], vb[16]; \
            TR_ITEM(cur, first_); tr_load(cur, va, lane); \
            for (int it0 = first_; it0 < end_; it0 += 2 * step_) { \
                const bool h1 = it0 + step_ < end_, h2 = it0 + 2 * step_ < end_; \
                if (h1) { TR_ITEM(nxt, it0 + step_); tr_load(nxt, vb, lane); } \
                tr_finish(cur, va, scr, lane); \
                if (h1) { if (h2) { TR_ITEM(cur, it0 + 2 * step_); tr_load(cur, va, lane); } tr_finish(nxt, vb, scr, lane); } } } } while (0)
__global__ void __launch_bounds__(NTHREADS, 2) fwd_megakernel(Args a) {
    extern __shared__ __attribute__((aligned(16))) unsigned char lds_raw[];
    cg::grid_group grid = cg::this_grid();
    lds_t* lds = (lds_t*)lds_raw;
#define PHASE_IDS int t__ = threadIdx.x; asm volatile("" : "+v"(t__)); const int tid = t__, lane = tid & 63, wid = __builtin_amdgcn_readfirstlane(tid >> 6), gw = bx * NWAVES + wid, NGW = G * NWAVES; (void)lane; (void)gw; (void)NGW;
    const int tid0 = threadIdx.x;
    const int G = gridDim.x, bx = blockIdx.x;
    unsigned char* ws = a.ws;
    unsigned* ctl = (unsigned*)(ws + WS_CTL);
    volatile LAS unsigned* xbst = (volatile LAS unsigned*)(lds + LDS_BYTES - 32);
    if (tid0 < 2) xbst[tid0] = 0u;
    __syncthreads();
    (void)xcd_barrier_post(ctl + 1024, xbst);
    if (gridDim.y == 0x7fffu) grid.sync();
#define GRID_BAR() do { XcdBarrier xb_; xb_.bar = (unsigned*)(a.ws + WS_CTL) + 1024; xb_.x = xb_xcc_id(); xb_.st = (volatile LAS unsigned*)(lds + LDS_BYTES - 32); xcd_barrier(xb_); } while (0)
    float* MOD = (float*)(ws + WS_MOD);
    const float* x = a.in[0];
    bf16_t* XN = (bf16_t*)(ws + WS_XN);
    bf16_t* MIX = (bf16_t*)(ws + WS_MIX);
    float* X1 = (float*)(ws + WS_X1);

#ifndef REP_P0
#define REP_P0 1
#endif
#ifndef REP_P3
#define REP_P3 1
#endif
#ifndef REP_P2
#define REP_P2 1
#endif
#ifndef REP_P6
#define REP_P6 1
#endif
    for (int rep = 0; rep < REP_P0; ++rep) {
        if (rep) GRID_BAR();
        PHASE_IDS
        const float* c = a.in[1]; const float* w_ada = a.in[2]; const float* b_ada = a.in[3];
        for (int item = bx; item < 256; item += G) {
            LAS float* sc = (LAS float*)lds; LAS f32x4* red = (LAS f32x4*)(lds + 16384);
            for (int i = tid; i < 4096; i += NTHREADS) { const float v = c[i]; sc[i] = v / (1.0f + __expf(-v)); }
            __syncthreads();
            const int c4 = tid % 12, rg = tid / 12;
            f32x4 a0 = {0.f, 0.f, 0.f, 0.f}, a1 = {0.f, 0.f, 0.f, 0.f};
            if (rg < 42) {
                const float* wp = w_ada + (size_t)rg * NMOD + item * 48 + c4 * 4;
#pragma unroll 7
                for (int i = 0; i < 49; ++i) { const int k = rg + 42 * i; if (k < 2048) { const f32x4 w = *(const f32x4*)(wp + (size_t)(42 * i) * NMOD); a0 += w * sc[k]; a1 += w * sc[2048 + k]; } }
                red[(rg * 12 + c4) * 2 + 0] = a0; red[(rg * 12 + c4) * 2 + 1] = a1;
            }
            __syncthreads();
            if (tid < 24) { const int bb = tid / 12, cc = tid % 12; f32x4 s = {0.f, 0.f, 0.f, 0.f};
                for (int r = 0; r < 42; ++r) s += red[(r * 12 + cc) * 2 + bb];
                const int n = item * 48 + cc * 4;
                *(f32x4*)(MOD + bb * NMOD + n) = s + *(const f32x4*)(b_ada + n); }
            __syncthreads();
        }
        f32x2* rotr = (f32x2*)(ws + WS_ROTR); f32x2* rotd = (f32x2*)(ws + WS_ROTD);
        for (int idx = bx * NTHREADS + tid; idx < 4096 * 64 + 4096 * 8; idx += G * NTHREADS) {
            float cc, ss;
            if (idx < 4096 * 64) { const int pos = idx >> 6, i = idx & 63; sincos_tab((double)pos * a.inv_r[i], cc, ss); rotr[idx] = (f32x2){cc, ss}; }
            else { const int e = idx - 4096 * 64, pos = e >> 3, i = e & 7; sincos_tab((double)pos * a.inv_d[i], cc, ss); rotd[e] = (f32x2){cc, ss}; }
        }
        if (bx == 0 && wid == 0) {
            const float s1 = wave_sum(a.in[8][lane] * a.in[9][lane]), s2 = wave_sum(a.in[10][lane] * a.in[11][lane]);
            if (lane == 0) MOD[2 * NMOD] = expf(s1) - expf(s2) + 0.2f;
        }
        TR_RUN(0, I_IN, gw, NGW);
    }
    GRID_BAR();
    { PHASE_IDS
    for (int m = gw; m < M; m += NGW) { const int b = m >> 12;
        norm_row<true, false>(x + (size_t)m * DM, a.in[4], MOD + b * NMOD + 0 * DM, MOD + b * NMOD + 1 * DM, XN + (size_t)m * DM, nullptr, lane); } }
    GRID_BAR();
    for (int rep = 0; rep < REP_P2; ++rep) {
        if (rep) GRID_BAR();
        pg8::Gemm g{XN, (const bf16_t*)(ws + WS_WIN), M, NPROJ, DM}; pg8::StaticOrder S; S.init(M, NPROJ, G, bx);
        EpiProj E{ws};
        pg8::gemm_phase<EpiProj, pg8::StaticOrder, true, true>(lds, g, S, E);
        {
            PHASE_IDS
            const int nwg = (M / 256) * (NPROJ / 256), rem = nwg % G;
            if (rem == 0) TR_RUN(I_IN, I_ALL, gw, NGW);
            else if (bx >= rem) TR_RUN(I_IN, I_ALL, (bx - rem) * NWAVES + wid, (G - rem) * NWAVES);
        }
    }
    GRID_BAR();
    for (int rep = 0; rep < REP_P3; ++rep) {
        if (rep) GRID_BAR();
        PHASE_IDS
        const float lam = __hip_atomic_load(MOD + 2 * NMOD, __ATOMIC_RELAXED, __HIP_MEMORY_SCOPE_AGENT);
        LAS int* qword = (LAS int*)(lds + LDS_BYTES - 64);
        for (;;) {
            if (tid == 0) *qword = (int)atomicAdd(ctl + 64 + 256 * rep, 1u);
            __syncthreads();
            const int idx = *qword;
            __syncthreads();
            if (idx >= 512 + 512) break;
            if (idx < 512) { const int qb = 31 - (idx >> 4), bh = idx & 15; attn_unit(lds, bh >> 3, bh & 7, qb, ws, a.in[12], lam, MIX); }
            else { const int u = idx - 512; ret_u_item(u >> 8, (u >> 5) & 7, u & 31, ws); }
        }
#ifdef PROBE_ATT
        for (;;) {
            if (tid == 0) *qword = (int)atomicAdd(ctl + 64 + 512, 1u);
            __syncthreads();
            const int idx = *qword;
            __syncthreads();
            if (idx >= 512) break;
            { const int qb = 31 - (idx >> 4), bh = idx & 15; attn_unit(lds, bh >> 3, bh & 7, qb, ws, a.in[12], lam, MIX); }
        }
#endif
#ifdef PROBE_RET
        GRID_BAR();
        for (int u = bx; u < 512; u += G) ret_u_item(u >> 8, (u >> 5) & 7, u & 31, ws);
        GRID_BAR();
        ret_scan(ws, bx * NTHREADS + tid, G * NTHREADS);
        GRID_BAR();
        for (int u = bx; u < 512; u += G) ret_c_item(lds, u >> 8, (u >> 5) & 7, u & 31, ws, a.in[7], MIX);
        for (int u = bx; u < 512; u += G) ret_u_item(u >> 8, (u >> 5) & 7, u & 31, ws);
#endif
        GRID_BAR();
        ret_scan(ws, bx * NTHREADS + tid, G * NTHREADS);
        GRID_BAR();
        for (int u = bx; u < 512; u += G) ret_c_item(lds, u >> 8, (u >> 5) & 7, u & 31, ws, a.in[7], MIX);
    }
    GRID_BAR();
    {
        pg8::Gemm g{MIX, (const bf16_t*)(ws + WS_WOUT), M, DM, DM}; pg8::StaticOrder S; S.init(M, DM, G, bx);
        EpiRes E{x, X1, MOD + 2 * DM};
        pg8::gemm_phase<EpiRes, pg8::StaticOrder, true, true>(lds, g, S, E);
    }
    GRID_BAR();
    { PHASE_IDS
    for (int m = gw; m < M; m += NGW) { const int b = m >> 12;
        norm_row<true, false>(X1 + (size_t)m * DM, a.in[5], MOD + b * NMOD + 3 * DM, MOD + b * NMOD + 4 * DM, XN + (size_t)m * DM, nullptr, lane); } }
    GRID_BAR();
    for (int rep = 0; rep < REP_P6; ++rep) {
        if (rep) GRID_BAR();
        pg8::Gemm g{XN, (const bf16_t*)(ws + WS_W1), M, FF, DM}; pg8::StaticOrder S; S.init(M, FF, G, bx);
        EpiRelu2 E{(bf16_t*)(ws + WS_U)};
        pg8::gemm_phase<EpiRelu2, pg8::StaticOrder, true, true>(lds, g, S, E);
    }
    GRID_BAR();
    {
        pg8::Gemm g{(const bf16_t*)(ws + WS_U), (const bf16_t*)(ws + WS_W2), M, DM, FF}; pg8::StaticOrder S; S.init(M, DM, G, bx);
        EpiRes E{X1, a.out, MOD + 5 * DM};
        pg8::gemm_phase<EpiRes, pg8::StaticOrder, true, true>(lds, g, S, E);
    }
    GRID_BAR();
    PHASE_IDS
    for (int m = gw; m < M; m += NGW) norm_row<false, true>(a.out + (size_t)m * DM, a.in[16], nullptr, nullptr, nullptr, a.out + (size_t)m * DM, lane);
}

extern "C" void kernel_launch(void* const* d_in, const int* in_sizes, int n_in, void* d_out, int out_size, void* d_ws, size_t ws_size, hipStream_t stream) {
    static int grid = 0;
    if (grid == 0) {
        if (n_in != 17 || in_sizes[0] != M * DM || out_size != M * DM || ws_size < WS_END) { fprintf(stderr, "kernel_launch: unexpected shapes (n_in %d, in0 %d, out %d, ws %zu)\n", n_in, n_in > 0 ? in_sizes[0] : -1, out_size, ws_size); grid = -1; return; }
        int dev = 0, cus = 0, per_cu = 0;
        if (hipGetDevice(&dev) != hipSuccess || hipDeviceGetAttribute(&cus, hipDeviceAttributeMultiprocessorCount, dev) != hipSuccess) { grid = -1; return; }
        if (hipFuncSetAttribute((const void*)fwd_megakernel, hipFuncAttributeMaxDynamicSharedMemorySize, LDS_BYTES) != hipSuccess) { fprintf(stderr, "kernel_launch: hipFuncSetAttribute failed\n"); grid = -1; return; }
        if (hipOccupancyMaxActiveBlocksPerMultiprocessor(&per_cu, (const void*)fwd_megakernel, NTHREADS, LDS_BYTES) != hipSuccess || per_cu < 1) { fprintf(stderr, "kernel_launch: occupancy query says %d blocks per CU\n", per_cu); (void)hipGetLastError(); grid = -1; return; }
        grid = cus;
    }
    if (grid < 0) return;
    (void)hipMemsetAsync((char*)d_ws + WS_CTL, 0, CTL_ZERO_BYTES, stream);
    Args a{};
    for (int i = 0; i < 17; ++i) a.in[i] = (const float*)d_in[i];
    a.out = (float*)d_out; a.ws = (unsigned char*)d_ws;
    for (int i = 0; i < 64; ++i) a.inv_r[i] = pow(10000.0, -(double)(2 * i) / 128.0);
    for (int i = 0; i < 8; ++i) a.inv_d[i] = pow(500000.0, -(double)(2 * i) / 16.0);
    void* args[] = {&a};
    hipError_t e = hipLaunchCooperativeKernel((const void*)fwd_megakernel, dim3(grid), dim3(NTHREADS), args, LDS_BYTES, stream);
    if (e != hipSuccess) fprintf(stderr, "kernel_launch: cooperative launch failed: %s (grid %d)\n", hipGetErrorString(e), grid);
}
```
